# Optimizing an MI355X kernel written in HIP

```python
import jax, jax.numpy as jnp
from jax import lax
import numpy as np

D_MODEL = 1024
BATCH = 1
SEQ = 16384
DEPTH = 2

N_META = 16
GRID_W = 64
N_HEADS = 8
N_KV_HEADS = 2
HEAD_DIM = 128
GQA_GROUP = N_HEADS // N_KV_HEADS
ATTN_WIDTH = N_HEADS * HEAD_DIM
KV_WIDTH = N_KV_HEADS * HEAD_DIM
ROT_HALF = HEAD_DIM // 2
ROPE_THETA = 10000.0
Q_BLOCK = 128
F_GROUPS = 4
F_GROUP_DIM = 128
F_WIDTH = F_GROUPS * F_GROUP_DIM
N_BRANCH = 2
IN_WIDTH = 2 * F_WIDTH + 2 * ATTN_WIDTH + 2 * KV_WIDTH + N_BRANCH * D_MODEL
EPS = 1e-6

kernel_name = "hybrid_fnet_axialgqa_gated_encoder"


def rms_norm(x, g):
    xf = x.astype(jnp.float32)
    y = xf * lax.rsqrt(jnp.mean(xf * xf, axis=-1, keepdims=True) + EPS)
    return (y * g.astype(jnp.float32)).astype(x.dtype)


def axial_angles(n_tokens):
    rows = n_tokens // GRID_W
    r = jnp.repeat(jnp.arange(rows, dtype=jnp.float32), GRID_W)
    c = jnp.tile(jnp.arange(GRID_W, dtype=jnp.float32), rows)
    pad = jnp.zeros((N_META,), jnp.float32)
    r = jnp.concatenate([pad, r])
    c = jnp.concatenate([pad, c])
    inv_freq = ROPE_THETA ** (-jnp.arange(0, ROT_HALF, 2, dtype=jnp.float32) / ROT_HALF)
    return r[:, None] * inv_freq[None, :], c[:, None] * inv_freq[None, :]


def rope_1d(x, ang):
    x1, x2 = jnp.split(x, 2, axis=-1)
    c = jnp.cos(ang)[:, None, :].astype(x.dtype)
    s = jnp.sin(ang)[:, None, :].astype(x.dtype)
    return jnp.concatenate([x1 * c - x2 * s, x2 * c + x1 * s], axis=-1)


def axial_rope(x, ang_r, ang_c):
    return jnp.concatenate([rope_1d(x[..., :ROT_HALF], ang_r), rope_1d(x[..., ROT_HALF:], ang_c)], axis=-1)


def attend(qb, k, v):
    scale = HEAD_DIM ** -0.5
    s = jnp.einsum('bqkgd,bskd->bkgqs', qb, k).astype(jnp.float32) * scale
    p = jax.nn.softmax(s, axis=-1).astype(v.dtype)
    return jnp.einsum('bkgqs,bskd->bqkgd', p, v)


def bidirectional_gqa(q, k, v):
    b, s_tot = q.shape[0], q.shape[1]
    n_real = s_tot - N_META
    q = q.reshape(b, s_tot, N_KV_HEADS, GQA_GROUP, HEAD_DIM)
    o_meta = attend(q[:, :N_META], k, v)
    q_real = q[:, N_META:].reshape(b, n_real // Q_BLOCK, Q_BLOCK, N_KV_HEADS, GQA_GROUP, HEAD_DIM)
    q_real = jnp.transpose(q_real, (1, 0, 2, 3, 4, 5))
    o_real = lax.map(lambda qb: attend(qb, k, v), q_real)
    o_real = jnp.transpose(o_real, (1, 0, 2, 3, 4, 5)).reshape(b, n_real, N_KV_HEADS, GQA_GROUP, HEAD_DIM)
    o = jnp.concatenate([o_meta, o_real], axis=1)
    return o.reshape(b, s_tot, ATTN_WIDTH)


def fourier_mix(u, w_mix):
    b, s, _ = u.shape
    uf = u.astype(jnp.float32).reshape(b, s, F_GROUPS, F_GROUP_DIM)
    z = jnp.fft.fft2(uf, axes=(1, 3), norm='ortho').real.astype(u.dtype)
    return jnp.einsum('bsgc,gcd->bsgd', z, w_mix).reshape(b, s, F_WIDTH)


def hybrid_layer(h, g_norm, w_in, b_gate, q_g, k_g, w_fmix, w_fproj, w_aproj, w_out, ang_r, ang_c):
    b, s, _ = h.shape
    xn = rms_norm(h, g_norm)
    proj = xn @ w_in
    p1 = F_WIDTH
    p2 = p1 + F_WIDTH
    p3 = p2 + ATTN_WIDTH
    p4 = p3 + KV_WIDTH
    p5 = p4 + KV_WIDTH
    p6 = p5 + ATTN_WIDTH
    f_val, f_gate, q, k, v, a_gate, gate_logits = jnp.split(proj, [p1, p2, p3, p4, p5, p6], axis=-1)
    y_f = (fourier_mix(f_val, w_fmix) * jax.nn.silu(f_gate)) @ w_fproj
    q = axial_rope(rms_norm(q.reshape(b, s, N_HEADS, HEAD_DIM), q_g), ang_r, ang_c)
    k = axial_rope(rms_norm(k.reshape(b, s, N_KV_HEADS, HEAD_DIM), k_g), ang_r, ang_c)
    v = v.reshape(b, s, N_KV_HEADS, HEAD_DIM)
    o = bidirectional_gqa(q, k, v)
    y_a = (o * jax.nn.silu(a_gate)) @ w_aproj
    gates = jax.nn.sigmoid(gate_logits + b_gate)
    g_f, g_a = jnp.split(gates, 2, axis=-1)
    return h + (g_f * y_f + g_a * y_a) @ w_out


def setup_inputs(seed: int = 0) -> dict:
    key = jax.random.key(seed)
    ks = jax.random.split(key, 12)
    f32 = jnp.float32
    x = jax.random.normal(ks[0], (BATCH, SEQ, D_MODEL), f32)
    meta_tokens = jax.random.normal(ks[1], (N_META, D_MODEL), f32)
    norm_g = 1.0 + 0.02 * jax.random.normal(ks[2], (DEPTH, D_MODEL), f32)
    w_in = jax.random.normal(ks[3], (DEPTH, D_MODEL, IN_WIDTH), f32) * D_MODEL ** -0.5
    b_gate = 0.02 * jax.random.normal(ks[4], (DEPTH, N_BRANCH * D_MODEL), f32)
    q_norm_g = 1.0 + 0.02 * jax.random.normal(ks[5], (DEPTH, HEAD_DIM), f32)
    k_norm_g = 1.0 + 0.02 * jax.random.normal(ks[6], (DEPTH, HEAD_DIM), f32)
    w_fmix = jax.random.normal(ks[7], (DEPTH, F_GROUPS, F_GROUP_DIM, F_GROUP_DIM), f32) * F_GROUP_DIM ** -0.5
    w_fproj = jax.random.normal(ks[8], (DEPTH, F_WIDTH, D_MODEL), f32) * F_WIDTH ** -0.5
    w_aproj = jax.random.normal(ks[9], (DEPTH, ATTN_WIDTH, D_MODEL), f32) * ATTN_WIDTH ** -0.5
    w_out = jax.random.normal(ks[10], (DEPTH, D_MODEL, D_MODEL), f32) * D_MODEL ** -0.5
    return {"x": x, "meta_tokens": meta_tokens, "norm_g": norm_g, "w_in": w_in, "b_gate": b_gate,
            "q_norm_g": q_norm_g, "k_norm_g": k_norm_g, "w_fmix": w_fmix, "w_fproj": w_fproj,
            "w_aproj": w_aproj, "w_out": w_out}


def reference(x, meta_tokens, norm_g, w_in, b_gate, q_norm_g, k_norm_g, w_fmix, w_fproj, w_aproj, w_out):
    b = x.shape[0]
    meta = jnp.broadcast_to(meta_tokens[None].astype(x.dtype), (b, N_META, x.shape[2]))
    h = jnp.concatenate([meta, x], axis=1)
    ang_r, ang_c = axial_angles(x.shape[1])
    for l in range(DEPTH):
        h = hybrid_layer(h, norm_g[l], w_in[l], b_gate[l], q_norm_g[l], k_norm_g[l], w_fmix[l],
                         w_fproj[l], w_aproj[l], w_out[l], ang_r, ang_c)
    return h[:, N_META:]
```

```cpp
#include <hip/hip_runtime.h>
#include <hip/hip_bf16.h>
#include <hip/hip_cooperative_groups.h>
#include <cstdio>
namespace cg = cooperative_groups;
namespace pg8 {
#define PG8_LAS __attribute__((address_space(3)))
typedef unsigned short bf16_t;
typedef short bf16x8 __attribute__((ext_vector_type(8)));
typedef float f32x4 __attribute__((ext_vector_type(4)));
typedef unsigned u32x4 __attribute__((ext_vector_type(4)));
constexpr int BM = 256, BK = 64, HALF = 128, HTB = HALF * BK * 2  , STAGE_BYTES = 8 * HTB, NXCD = 8, WGM = 8;

__host__ __device__ __forceinline__ int lds_byte(int r, int c) { const int st = (r >> 4) * 2 + (c >> 5), rr = r & 15, cc = c & 31, ob = rr * 64 + cc * 2; return st * 1024 + (ob ^ (((ob >> 9) & 1) << 5)); }
__host__ __device__ __forceinline__ void stage_rc(int b, int& R, int& C) { const int st = b / 1024, sb = b % 1024, swz = sb ^ (((sb >> 9) & 1) << 5); R = (st >> 1) * 16 + swz / 64; C = (st & 1) * 32 + (swz % 64) / 2; }
__host__ __device__ __forceinline__ int perm32(int rho) { const int n = rho >> 4, i = rho & 15; return 8 * (i >> 2) + 4 * n + (i & 3); }

struct Unit { int pm, pn; };
struct Gemm { const bf16_t* A; const bf16_t* Bt; int M, N, K; };

struct StaticOrder {
    int nM, nN, nwg, G, c;
    __host__ __device__ void init(int M, int N, int G_, int c_) { nM = M / BM; nN = N / BM; nwg = nM * nN; G = G_; c = c_; }
    __host__ __device__ bool next(int i, Unit& u) const {
        const long L = (long)i * G + c; if (L >= nwg) return false;
        int wgid = (int)L; { const int q = nwg / NXCD, r = nwg % NXCD, xcd = wgid % NXCD, off = wgid / NXCD; wgid = (xcd < r ? xcd * (q + 1) : r * (q + 1) + (xcd - r) * q) + off; }
        const int nig = WGM * nN, gid = wgid / nig, fm = gid * WGM, gsz = (nM - fm) < WGM ? (nM - fm) : WGM;
        u.pm = fm + ((wgid % nig) % gsz); u.pn = (wgid % nig) / gsz; return true;
    }
    __device__ __forceinline__ void a_ready(const Unit&) const {}
    __device__ __forceinline__ void done(const Unit&) const {}
};
template <class Epi, class Sched, bool STAMP = false>
__device__ __forceinline__ void gemm_phase(PG8_LAS unsigned char* lds, const Gemm g, const Sched& S, const Epi& E, unsigned long long* stamps) {
    int tid_l = threadIdx.x; asm volatile("" : "+v"(tid_l));
    const int tid = tid_l, wid = __builtin_amdgcn_readfirstlane(tid >> 6), lane = tid & 63, wr = wid >> 2, wc = wid & 3, fr = lane & 15, fq = lane >> 4;
    const int K = g.K, nt = K / BK;
    int ts_lo = 0, ts_hi = 0, nts = 0; const unsigned long long rt_entry = STAMP ? (unsigned long long)wall_clock64() : 0ull;
#define PG8_STAMP() do { if (STAMP && wid == 0 && nts < 64) { const unsigned long long _c = (unsigned long long)clock64(); \
        ts_lo = (lane == nts) ? (int)(unsigned)_c : ts_lo; ts_hi = (lane == nts) ? (int)(unsigned)(_c >> 32) : ts_hi; ++nts; } } while (0)
    PG8_STAMP();
    unsigned voffA[2], voffB[2];
#pragma unroll
    for (int i = 0; i < 2; ++i) { int R, C; stage_rc(tid * 16 + i * 8192, R, C); const int Rb = Epi::PERM ? ((R & ~31) + perm32(R & 31)) : R;
        voffA[i] = (unsigned)(R * K + C) * 2u; voffB[i] = (unsigned)(Rb * K + C) * 2u; }
    const size_t kstep = (size_t)(BK * 2);
    const size_t hstep = (size_t)HALF * K * 2;
    const size_t tstep = 2 * hstep;
    const unsigned ldsw = (unsigned)wid * 1024u;
    const int aoff = lds_byte(wr * 64 + fr, fq * 8), boff = lds_byte(wc * 32 + fr, fq * 8);
#define PG8_SA(b, h) (((b) * 2 + (h)) * HTB)
#define PG8_SB(b, h) ((4 + (b) * 2 + (h)) * HTB)
#define PG8_STAGE(bufoff, gbase, voff) do { _Pragma("unroll") for (int _i = 0; _i < 2; ++_i) \
        __builtin_amdgcn_global_load_lds((const unsigned*)((const char*)(gbase) + (voff)[_i]), (PG8_LAS unsigned*)(lds + (bufoff) + ldsw + _i * 8192), 16, 0, 0); } while (0)
#define PG8_LDA(dst, b, h) do { _Pragma("unroll") for (int m = 0; m < 4; ++m) _Pragma("unroll") for (int k = 0; k < 2; ++k) dst[m][k] = *(const PG8_LAS bf16x8*)(lds + PG8_SA(b, h) + aoff + m * 2048 + k * 1024); } while (0)
#define PG8_LDB(dst, b, h) do { _Pragma("unroll") for (int n = 0; n < 2; ++n) _Pragma("unroll") for (int k = 0; k < 2; ++k) dst[n][k] = *(const PG8_LAS bf16x8*)(lds + PG8_SB(b, h) + boff + n * 2048 + k * 1024); } while (0)
#define PG8_MMA(ai, bj, At, Bt) do { __builtin_amdgcn_s_setprio(1); _Pragma("unroll") for (int m = 0; m < 4; ++m) _Pragma("unroll") for (int n = 0; n < 2; ++n) _Pragma("unroll") for (int k = 0; k < 2; ++k) \
        acc[ai][bj][m][n] = __builtin_amdgcn_mfma_f32_16x16x32_bf16(Bt[n][k], At[m][k], acc[ai][bj][m][n], 0, 0, 0); __builtin_amdgcn_s_setprio(0); } while (0)
#define PG8_WAIT_V(n) asm volatile("s_waitcnt vmcnt(" #n ")" ::: "memory")
#define PG8_WAIT_L(n) asm volatile("s_waitcnt lgkmcnt(" #n ")" ::: "memory")
#define PG8_BAR __builtin_amdgcn_s_barrier()
#define PG8_SCHED __builtin_amdgcn_sched_barrier(0)
    Unit cur, nxt; int ui = 0;
    if (!S.next(0, cur)) return;
    f32x4 acc[2][2][4][2];
#pragma unroll
    for (int a = 0; a < 2; ++a)
#pragma unroll
        for (int b = 0; b < 2; ++b)
#pragma unroll
            for (int m = 0; m < 4; ++m)
#pragma unroll
                for (int n = 0; n < 2; ++n) acc[a][b][m][n] = (f32x4){0.f, 0.f, 0.f, 0.f};
    bf16x8 At[4][2], B0[2][2], B1[2][2];
    const char* cA = (const char*)g.A + (size_t)cur.pm * tstep; const char* cB = (const char*)g.Bt + (size_t)cur.pn * tstep;
    S.a_ready(cur);
    PG8_STAGE(PG8_SB(0, 0), cB, voffB); PG8_STAGE(PG8_SA(0, 0), cA, voffA); PG8_STAGE(PG8_SB(0, 1), cB + hstep, voffB); PG8_STAGE(PG8_SA(0, 1), cA + hstep, voffA);
    if (wr == 1) PG8_BAR;
    PG8_WAIT_V(4); PG8_BAR;
    PG8_STAGE(PG8_SB(1, 0), cB + kstep, voffB); PG8_STAGE(PG8_SA(1, 0), cA + kstep, voffA); PG8_STAGE(PG8_SB(1, 1), cB + hstep + kstep, voffB);
    PG8_WAIT_V(6); PG8_BAR;
    PG8_STAMP();
    for (;;) {
        const bool has_next = S.next(ui + 1, nxt);
        const char* nA = has_next ? (const char*)g.A + (size_t)nxt.pm * tstep : cA; const char* nB = has_next ? (const char*)g.Bt + (size_t)nxt.pn * tstep : cB;
#pragma unroll 1
        for (int t = 0; t < nt; t += 2) {
            const bool last = (t == nt - 2);
            const char* a1 = cA + (size_t)(t + 1) * kstep;
            const char* a2 = last ? nA : cA + (size_t)(t + 2) * kstep; const char* b2 = last ? nB : cB + (size_t)(t + 2) * kstep;
            const char* a3 = a2 + kstep; const char* b3 = b2 + kstep;
            if (last && has_next) S.a_ready(nxt);
            PG8_LDB(B0, 0, 0); PG8_SCHED; PG8_LDA(At, 0, 0); PG8_STAGE(PG8_SA(1, 1), a1 + hstep, voffA);
            PG8_WAIT_L(8); PG8_BAR; PG8_WAIT_L(0); PG8_MMA(0, 0, At, B0); PG8_BAR; PG8_SCHED;
            PG8_LDB(B1, 0, 1); PG8_STAGE(PG8_SB(0, 0), b2, voffB);
            PG8_BAR; PG8_WAIT_L(0); PG8_MMA(0, 1, At, B1); PG8_BAR;
            PG8_LDA(At, 0, 1); PG8_STAGE(PG8_SA(0, 0), a2, voffA);
            PG8_BAR; PG8_WAIT_L(0); PG8_MMA(1, 0, At, B0); PG8_BAR; PG8_SCHED;
            PG8_STAGE(PG8_SB(0, 1), b2 + hstep, voffB);
            PG8_WAIT_V(6); PG8_BAR; PG8_MMA(1, 1, At, B1); PG8_BAR;
            PG8_LDB(B0, 1, 0); PG8_SCHED; PG8_LDA(At, 1, 0); PG8_STAGE(PG8_SA(0, 1), a2 + hstep, voffA);
            PG8_WAIT_L(8); PG8_BAR; PG8_WAIT_L(0); PG8_MMA(0, 0, At, B0); PG8_BAR; PG8_SCHED;
            PG8_LDB(B1, 1, 1); PG8_STAGE(PG8_SB(1, 0), b3, voffB);
            PG8_BAR; PG8_WAIT_L(0); PG8_MMA(0, 1, At, B1); PG8_BAR;
            PG8_LDA(At, 1, 1); PG8_STAGE(PG8_SA(1, 0), a3, voffA);
            PG8_BAR; PG8_WAIT_L(0); PG8_MMA(1, 0, At, B0); PG8_BAR; PG8_SCHED;
            PG8_STAGE(PG8_SB(1, 1), b3 + hstep, voffB);
            PG8_WAIT_V(6); PG8_BAR; PG8_MMA(1, 1, At, B1); PG8_BAR;
        }
        PG8_STAMP();
        if constexpr (!Epi::AFTER_DRAIN) { E(acc, cur, wr, wc, fr, fq); S.done(cur); }
        PG8_STAMP();
        if (!has_next) break;
#pragma unroll
        for (int a = 0; a < 2; ++a)
#pragma unroll
            for (int b = 0; b < 2; ++b)
#pragma unroll
                for (int m = 0; m < 4; ++m)
#pragma unroll
                    for (int n = 0; n < 2; ++n) acc[a][b][m][n] = (f32x4){0.f, 0.f, 0.f, 0.f};
        cur = nxt; cA = nA; cB = nB; ++ui;
    }
    PG8_WAIT_V(0);
    if (wr == 0) PG8_BAR;
    PG8_BAR;
    if constexpr (Epi::AFTER_DRAIN) { E.fused(acc, cur, wr, wc, fr, fq, lds, wid, lane); S.done(cur); }
    PG8_STAMP();
    if (STAMP && wid == 0) { stamps[lane] = lane < nts ? (((unsigned long long)(unsigned)ts_hi << 32) | (unsigned)ts_lo) : 0ull;
        if (lane == 62) stamps[62] = rt_entry; if (lane == 63) stamps[63] = (unsigned long long)wall_clock64(); }
#undef PG8_STAMP
#undef PG8_SA
#undef PG8_SB
#undef PG8_STAGE
#undef PG8_LDA
#undef PG8_LDB
#undef PG8_MMA
#undef PG8_WAIT_V
#undef PG8_WAIT_L
#undef PG8_BAR
#undef PG8_SCHED
}
}

typedef unsigned short u16;
using pg8::bf16x8; using pg8::f32x4; using pg8::u32x4;
typedef short s16x4 __attribute__((ext_vector_type(4)));
typedef float f32x16 __attribute__((ext_vector_type(16)));
typedef float f32x2 __attribute__((ext_vector_type(2)));
typedef unsigned u32x2 __attribute__((ext_vector_type(2)));

constexpr int DM = 1024, SEQ = 16384, NMETA = 16, ST = 16400, TPAD = 16512, INW = 5632;
constexpr int FN1 = 164, FN2 = 100;
constexpr float EPS = 1e-6f;
constexpr size_t SZ_WIN = (size_t)INW * DM * 2, SZ_WFP = (size_t)1024 * 512 * 2, SZ_W1K = (size_t)1024 * 1024 * 2, SZ_MMIX = (size_t)512 * 1024 * 2;
constexpr size_t OFF_WIN = 0, OFF_WFP = OFF_WIN + 2 * SZ_WIN, OFF_WAP = OFF_WFP + 2 * SZ_WFP, OFF_WOUT = OFF_WAP + 2 * SZ_W1K, OFF_MMIX = OFF_WOUT + 2 * SZ_W1K;
constexpr size_t OFF_F1T = OFF_MMIX + 2 * SZ_MMIX, OFF_F2T = OFF_F1T + 512 * 256 * 2, OFF_TW = OFF_F2T + 256 * 256 * 2, OFF_CS = OFF_TW + 131328;
constexpr size_t OFF_HB = OFF_CS + 65536, SZ_T1K = (size_t)TPAD * 1024 * 2, OFF_SSQ = OFF_HB + SZ_T1K, OFF_HMETA = OFF_SSQ + (size_t)ST * 16 * 4;
constexpr size_t OFF_RSTD = OFF_HMETA + 65536, OFF_T = OFF_RSTD + 65792, SZ_T512 = (size_t)TPAD * 512 * 2, OFF_K = OFF_T + SZ_T512, SZ_T256 = (size_t)TPAD * 256 * 2, OFF_V = OFF_K + SZ_T256, OFF_X = OFF_V + SZ_T256;
constexpr size_t OFF_Q = OFF_X, OFF_AG = OFF_Q + SZ_T1K, OFF_GT = OFF_AG + SZ_T1K, OFF_XEND = OFF_GT + 2 * SZ_T1K;
constexpr size_t SZ_UT = (size_t)512 * FN2 * 256 * 2, SZ_YT = (size_t)FN1 * 512 * 256 * 2;
constexpr size_t OFF_UT = OFF_X, OFF_YT = OFF_UT + SZ_UT, OFF_WB = OFF_YT + SZ_YT, OFF_FG = OFF_WB + SZ_T1K, OFF_XEND2 = OFF_FG + SZ_T512;
static_assert(OFF_XEND2 <= OFF_XEND, "FFT buffers must fit in the X region");
static_assert(OFF_XEND <= (size_t)256 * 1024 * 1024, "workspace over 256 MiB");
constexpr int LDS_BYTES = 131072 + 1024;

struct Params { const float *x, *meta, *norm_g, *w_in, *b_gate, *q_g, *k_g, *w_fmix, *w_fproj, *w_aproj, *w_out; float* out; unsigned char* ws; };

__device__ __forceinline__ int ltid() { int t = threadIdx.x; asm volatile("" : "+v"(t)); return t; }
__device__ __forceinline__ unsigned cvtpk(float lo, float hi) { unsigned r; asm volatile("v_cvt_pk_bf16_f32 %0, %1, %2" : "=v"(r) : "v"(lo), "v"(hi)); return r; }
__device__ __forceinline__ u16 f2bf(float x) { return (u16)(cvtpk(x, 0.f) & 0xffffu); }
__device__ __forceinline__ float bf2f(u16 b) { return __uint_as_float(((unsigned)b) << 16); }
__device__ __forceinline__ float bflo(unsigned w) { return __uint_as_float(w << 16); }
__device__ __forceinline__ float bfhi(unsigned w) { return __uint_as_float(w & 0xffff0000u); }
__device__ __forceinline__ u32x4 pack8(f32x4 a, f32x4 b) { u32x4 w; w.x = cvtpk(a[0], a[1]); w.y = cvtpk(a[2], a[3]); w.z = cvtpk(b[0], b[1]); w.w = cvtpk(b[2], b[3]); return w; }
__device__ __forceinline__ float silu_f(float x) { return x / (1.f + __expf(-x)); }
__device__ __forceinline__ float sigm_f(float x) { return 1.f / (1.f + __expf(-x)); }
__device__ __forceinline__ float wave_sum(float v) { for (int o = 32; o > 0; o >>= 1) v += __shfl_xor(v, o); return v; }
__device__ __forceinline__ float rstd_from_ssqp(const float* sp) {
  const f32x4 a = *(const f32x4*)sp, b = *(const f32x4*)(sp + 4), c = *(const f32x4*)(sp + 8), d = *(const f32x4*)(sp + 12);
  const float s = ((a[0] + a[1]) + (a[2] + a[3])) + ((b[0] + b[1]) + (b[2] + b[3])) + ((c[0] + c[1]) + (c[2] + c[3])) + ((d[0] + d[1]) + (d[2] + d[3]));
  return rsqrtf(s * (1.f / 1024.f) + EPS);
}
#define EPI_ROWS for (int ai = 0; ai < 2; ++ai) _Pragma("unroll") for (int m = 0; m < 4; ++m)
#define ROW_FENCE() do { asm volatile("" ::: "memory"); __builtin_amdgcn_sched_barrier(0); } while (0)
struct EpiA {
  static constexpr bool PERM = true, AFTER_DRAIN = false;
  const float* rstd; u16 *ut, *fg, *kb, *vb;
  __device__ __forceinline__ void operator()(const f32x4 (&acc)[2][2][4][2], const pg8::Unit& u, int wr, int wc, int fr, int fq) const {
#pragma unroll
    EPI_ROWS {
      ROW_FENCE();
      const int s = 16 + u.pm * 256 + ai * 128 + wr * 64 + m * 16 + fr;
      const float rs = rstd[s];
#pragma unroll
      for (int bj = 0; bj < 2; ++bj) {
        const int col = u.pn * 256 + bj * 128 + wc * 32 + 8 * fq;
        const f32x4 v0 = acc[ai][bj][m][0] * rs, v1 = acc[ai][bj][m][1] * rs;
        if (u.pn < 2) {
          const int s1 = s / FN2, s2 = s - s1 * FN2; u16* d = ut + ((size_t)col * FN2 + s2) * 256 + s1;
#pragma unroll
          for (int j = 0; j < 4; ++j) { d[(size_t)j * (FN2 * 256)] = f2bf(v0[j]); d[(size_t)(4 + j) * (FN2 * 256)] = f2bf(v1[j]); }
        } else {
          u16* d = (u.pn < 4) ? fg + (size_t)s * 512 + (col - 512) : (u.pn == 4 ? kb + (size_t)s * 256 + (col - 1024) : vb + (size_t)s * 256 + (col - 1280));
          *(u32x4*)d = pack8(v0, v1);
        }
      }
    }
  }
};
struct EpiF1 {
  static constexpr bool PERM = false, AFTER_DRAIN = false;
  const float* tw; u16* yt;
  __device__ __forceinline__ void operator()(const f32x4 (&acc)[2][2][4][2], const pg8::Unit& u, int wr, int wc, int fr, int fq) const {
#pragma unroll
    for (int m = 0; m < 4; ++m) {
      const int k1 = u.pm * 128 + wr * 64 + m * 16 + fr;
      if (k1 < FN1) {
#pragma unroll
        for (int bj = 0; bj < 2; ++bj)
#pragma unroll
          for (int n = 0; n < 2; ++n) {
            ROW_FENCE();
            const int c0 = u.pn * 256 + bj * 128 + wc * 32 + n * 16 + 4 * fq, colx = c0 / FN2, s2 = c0 - colx * FN2;
            const f32x4 re = acc[0][bj][m][n], im = acc[1][bj][m][n];
            const float* tp = tw + (size_t)(k1 * FN2 + s2) * 2; const f32x4 t0 = *(const f32x4*)tp, t1 = *(const f32x4*)(tp + 4);
            const float yr0 = re[0] * t0[0] - im[0] * t0[1], yi0 = re[0] * t0[1] + im[0] * t0[0];
            const float yr1 = re[1] * t0[2] - im[1] * t0[3], yi1 = re[1] * t0[3] + im[1] * t0[2];
            const float yr2 = re[2] * t1[0] - im[2] * t1[1], yi2 = re[2] * t1[1] + im[2] * t1[0];
            const float yr3 = re[3] * t1[2] - im[3] * t1[3], yi3 = re[3] * t1[3] + im[3] * t1[2];
            u16* d = yt + ((size_t)k1 * 512 + colx) * 256 + s2;
            u32x2 a; a.x = cvtpk(yr0, yr1); a.y = cvtpk(yr2, yr3); *(u32x2*)d = a;
            u32x2 b; b.x = cvtpk(yi0, yi1); b.y = cvtpk(yi2, yi3); *(u32x2*)(d + 128) = b;
          }
      }
    }
  }
};
struct EpiF2 {
  static constexpr bool PERM = true, AFTER_DRAIN = false;
  u16* wb;
  __device__ __forceinline__ void operator()(const f32x4 (&acc)[2][2][4][2], const pg8::Unit& u, int wr, int wc, int fr, int fq) const {
#pragma unroll
    EPI_ROWS {
      ROW_FENCE();
      const int k2 = wr * 64 + m * 16 + fr;
      if (k2 < FN2) {
#pragma unroll
        for (int bj = 0; bj < 2; ++bj) {
          const int n = u.pn * 256 + bj * 128 + wc * 32 + 8 * fq, k1 = n >> 9, col = n & 511, g = col >> 7, c = col & 127;
          *(u32x4*)(wb + (size_t)(k1 + FN1 * k2) * 1024 + g * 256 + ai * 128 + c) = pack8(acc[ai][bj][m][0], acc[ai][bj][m][1]);
        }
      }
    }
  }
};
struct EpiMix {
  static constexpr bool PERM = true, AFTER_DRAIN = false;
  const u16* fg; u16* t;
  __device__ __forceinline__ void operator()(const f32x4 (&acc)[2][2][4][2], const pg8::Unit& u, int wr, int wc, int fr, int fq) const {
#pragma unroll
    EPI_ROWS {
      ROW_FENCE();
      const int s = 16 + u.pm * 256 + ai * 128 + wr * 64 + m * 16 + fr;
#pragma unroll
      for (int bj = 0; bj < 2; ++bj) {
        const int col = u.pn * 256 + bj * 128 + wc * 32 + 8 * fq;
        const u32x4 g = *(const u32x4*)(fg + (size_t)s * 512 + col); f32x4 v0 = acc[ai][bj][m][0], v1 = acc[ai][bj][m][1];
        v0[0] *= silu_f(bflo(g.x)); v0[1] *= silu_f(bfhi(g.x)); v0[2] *= silu_f(bflo(g.y)); v0[3] *= silu_f(bfhi(g.y));
        v1[0] *= silu_f(bflo(g.z)); v1[1] *= silu_f(bfhi(g.z)); v1[2] *= silu_f(bflo(g.w)); v1[3] *= silu_f(bfhi(g.w));
        *(u32x4*)(t + (size_t)s * 512 + col) = pack8(v0, v1);
      }
    }
  }
};
struct EpiE {
  static constexpr bool PERM = true, AFTER_DRAIN = false;
  const float* rstd; const float* bg; u16 *q, *ag, *gt;
  __device__ __forceinline__ void operator()(const f32x4 (&acc)[2][2][4][2], const pg8::Unit& u, int wr, int wc, int fr, int fq) const {
#pragma unroll
    EPI_ROWS {
      ROW_FENCE();
      const int s = 16 + u.pm * 256 + ai * 128 + wr * 64 + m * 16 + fr;
      const float rs = rstd[s];
#pragma unroll
      for (int bj = 0; bj < 2; ++bj) {
        const int col = u.pn * 256 + bj * 128 + wc * 32 + 8 * fq;
        f32x4 v0 = acc[ai][bj][m][0] * rs, v1 = acc[ai][bj][m][1] * rs;
        if (u.pn < 4) *(u32x4*)(q + (size_t)s * 1024 + col) = pack8(v0, v1);
        else if (u.pn < 8) *(u32x4*)(ag + (size_t)s * 1024 + (col - 1024)) = pack8(v0, v1);
        else {
          const f32x4 b0 = *(const f32x4*)(bg + col - 2048), b1 = *(const f32x4*)(bg + col - 2048 + 4);
#pragma unroll
          for (int j = 0; j < 4; ++j) { v0[j] = sigm_f(v0[j] + b0[j]); v1[j] = sigm_f(v1[j] + b1[j]); }
          *(u32x4*)(gt + (size_t)s * 2048 + (col - 2048)) = pack8(v0, v1);
        }
      }
    }
  }
};
template <int SECOND> struct EpiG {
  static constexpr bool PERM = true, AFTER_DRAIN = false;
  const u16* gt; u16* mb;
  __device__ __forceinline__ void operator()(const f32x4 (&acc)[2][2][4][2], const pg8::Unit& u, int wr, int wc, int fr, int fq) const {
#pragma unroll
    EPI_ROWS {
      ROW_FENCE();
      const int s = 16 + u.pm * 256 + ai * 128 + wr * 64 + m * 16 + fr;
#pragma unroll
      for (int bj = 0; bj < 2; ++bj) {
        const int col = u.pn * 256 + bj * 128 + wc * 32 + 8 * fq;
        const u32x4 g = *(const u32x4*)(gt + (size_t)s * 2048 + SECOND * 1024 + col); f32x4 v0 = acc[ai][bj][m][0], v1 = acc[ai][bj][m][1];
        v0[0] *= bflo(g.x); v0[1] *= bfhi(g.x); v0[2] *= bflo(g.y); v0[3] *= bfhi(g.y); v1[0] *= bflo(g.z); v1[1] *= bfhi(g.z); v1[2] *= bflo(g.w); v1[3] *= bfhi(g.w);
        u16* d = mb + (size_t)s * 1024 + col;
        if (SECOND) { const u32x4 p = *(const u32x4*)d; v0[0] += bflo(p.x); v0[1] += bfhi(p.x); v0[2] += bflo(p.y); v0[3] += bfhi(p.y); v1[0] += bflo(p.z); v1[1] += bfhi(p.z); v1[2] += bflo(p.w); v1[3] += bfhi(p.w); }
        *(u32x4*)d = pack8(v0, v1);
      }
    }
  }
};
struct EpiH {
  static constexpr bool PERM = true, AFTER_DRAIN = false;
  const float* hin; float* hout; u16* hb; float* ssqp;
  __device__ __forceinline__ void operator()(const f32x4 (&acc)[2][2][4][2], const pg8::Unit& u, int wr, int wc, int fr, int fq) const {
#pragma unroll
    EPI_ROWS {
      ROW_FENCE();
      const int r = u.pm * 256 + ai * 128 + wr * 64 + m * 16 + fr; float ss = 0.f;
#pragma unroll
      for (int bj = 0; bj < 2; ++bj) {
        const int col = u.pn * 256 + bj * 128 + wc * 32 + 8 * fq;
        const float* hp = hin + (size_t)r * 1024 + col;
        const f32x4 v0 = acc[ai][bj][m][0] + *(const f32x4*)hp, v1 = acc[ai][bj][m][1] + *(const f32x4*)(hp + 4);
        float* op = hout + (size_t)r * 1024 + col; *(f32x4*)op = v0; *(f32x4*)(op + 4) = v1;
        *(u32x4*)(hb + (size_t)(16 + r) * 1024 + col) = pack8(v0, v1);
#pragma unroll
        for (int j = 0; j < 4; ++j) ss += v0[j] * v0[j] + v1[j] * v1[j];
      }
      ss += __shfl_xor(ss, 16); ss += __shfl_xor(ss, 32);
      if (fq == 0) ssqp[(size_t)(16 + r) * 16 + u.pn * 4 + wc] = ss;
    }
  }
};
__device__ __forceinline__ void fix_row(u16* p, const float* g, int s, const float* cs, int lane) {
  const int a = (lane & 31) + ((lane >> 5) << 6);
  const float x1 = bf2f(p[a]), x2 = bf2f(p[a + 32]);
  const float ss = wave_sum(x1 * x1 + x2 * x2);
  const float rs = rsqrtf(ss * (1.f / 128.f) + EPS);
  const float y1 = x1 * rs * g[a], y2 = x2 * rs * g[a + 32];
  float c = 1.f, sn = 0.f;
  if (s >= 16) { const int t = s - 16, pos = (lane < 32) ? (t >> 6) : (t & 63); const f32x2 v = *(const f32x2*)(cs + (size_t)(pos * 32 + (lane & 31)) * 2); c = v.x; sn = v.y; }
  p[a] = f2bf(y1 * c - y2 * sn); p[a + 32] = f2bf(y2 * c + y1 * sn);
}

namespace att {
constexpr int D = 128, NW = 8, QBLK = 32, KVBLK = 64, LDQ = 1024, LDK = 256, LDO = 1024, KVALID = ST, NT = TPAD / KVBLK;
constexpr float SCALE = 0.088388347648318440f, THR = 8.f;
constexpr size_t SHM_V = KVBLK * D * 2, SHM_K = KVBLK * D * 2;
#define KSWZ(row, colB) ((row) * 256 + ((colB) ^ (((row) & 7) << 4)))
#define SBAR() __builtin_amdgcn_sched_barrier(0)
__device__ __forceinline__ int crow(int r, int hi) { return (r & 3) + 8 * (r >> 2) + 4 * hi; }
template <int MODE>
__device__ __forceinline__ void partialSM(f32x16& p0, f32x16& p1, float& m_reg, float& mn, float& alpha) {
  constexpr float C = SCALE * 1.4426950408889634f;
  if (MODE == 1) {
#pragma unroll
    for (int r = 8; r < 16; ++r) p0[r] = -1e30f;
  }
  if (MODE == 2) {
#pragma unroll
    for (int r = 0; r < 16; ++r) p0[r] = -1e30f;
  }
  if (MODE >= 1) {
#pragma unroll
    for (int r = 0; r < 16; ++r) p1[r] = -1e30f;
  }
  float pmax = p0[0];
#pragma unroll
  for (int r = 1; r < 16; ++r) pmax = fmaxf(pmax, p0[r]);
#pragma unroll
  for (int r = 0; r < 16; ++r) pmax = fmaxf(pmax, p1[r]);
  { auto rr = __builtin_amdgcn_permlane32_swap(__float_as_uint(pmax), __float_as_uint(pmax), false, false);
    pmax = fmaxf(__uint_as_float(rr[0]), __uint_as_float(rr[1])); }
  if (__builtin_expect(__all(pmax - m_reg <= THR / SCALE), 1)) { mn = m_reg; alpha = 1.f; }
  else { mn = fmaxf(m_reg, pmax); alpha = __builtin_amdgcn_exp2f((m_reg - mn) * C); m_reg = mn; }
  const float mnC = -mn * C;
#pragma unroll
  for (int r = 0; r < 16; ++r) p0[r] = fmaf(p0[r], C, mnC);
#pragma unroll
  for (int r = 0; r < 16; ++r) p1[r] = fmaf(p1[r], C, mnC);
#pragma unroll
  for (int r = 0; r < 16; ++r) p0[r] = __builtin_amdgcn_exp2f(p0[r]);
}
__device__ __forceinline__ void finishSM(f32x16& p0, f32x16& p1, float alpha, float& l_reg, bf16x8& pa0, bf16x8& pa1, bf16x8& pa2, bf16x8& pa3) {
#pragma unroll
  for (int r = 0; r < 16; ++r) p1[r] = __builtin_amdgcn_exp2f(p1[r]);
  float ps = 0;
#pragma unroll
  for (int r = 0; r < 16; ++r) ps += p0[r];
#pragma unroll
  for (int r = 0; r < 16; ++r) ps += p1[r];
  { auto rr = __builtin_amdgcn_permlane32_swap(__float_as_uint(ps), __float_as_uint(ps), false, false);
    ps = __uint_as_float(rr[0]) + __uint_as_float(rr[1]); }
  l_reg = l_reg * alpha + ps;
#define PK4(P, BASE, OUT) do { unsigned a0 = cvtpk(P[BASE + 0], P[BASE + 1]), a1 = cvtpk(P[BASE + 2], P[BASE + 3]);   \
    unsigned b0 = cvtpk(P[BASE + 4], P[BASE + 5]), b1 = cvtpk(P[BASE + 6], P[BASE + 7]);                              \
    auto r0 = __builtin_amdgcn_permlane32_swap(a0, b0, false, false); auto r1 = __builtin_amdgcn_permlane32_swap(a1, b1, false, false); \
    u32x4 w = {r0[0], r1[0], r0[1], r1[1]}; OUT = *reinterpret_cast<bf16x8*>(&w); } while (0)
  PK4(p0, 0, pa0); PK4(p0, 8, pa1); PK4(p1, 0, pa2); PK4(p1, 8, pa3);
#undef PK4
}
__device__ __forceinline__ void qkt(f32x16& p0, f32x16& p1, const char* Ks, const bf16x8* qr, int r32, int hi) {
  p0 = f32x16{}; p1 = f32x16{};
#pragma unroll
  for (int d0 = 0; d0 < 8; ++d0) { const int cb = (d0 * 16 + hi * 8) * 2;
    const bf16x8 b0 = *reinterpret_cast<const bf16x8*>(Ks + KSWZ(r32, cb));
    const bf16x8 b1 = *reinterpret_cast<const bf16x8*>(Ks + KSWZ(32 + r32, cb));
    p0 = __builtin_amdgcn_mfma_f32_32x32x16_bf16(b0, qr[d0], p0, 0, 0, 0);
    p1 = __builtin_amdgcn_mfma_f32_32x32x16_bf16(b1, qr[d0], p1, 0, 0, 0); }
}
__device__ __forceinline__ int v_st(int k, int c) { const int kk = (k & ~0xC) | ((k & 4) << 1) | ((k & 8) >> 1); return ((kk >> 3) * 4 + (c >> 5)) * 512 + ((kk & 7) * 32 + (c & 31)) * 2; }
__device__ __forceinline__ int v_rd_base(int lane) { return ((lane & 3) << 3) | (((lane >> 2) & 3) << 6) | (((lane >> 4) & 1) << 5) | (((lane >> 5) & 1) << 8); }
constexpr int v_rd_off(int d0, int ks, int half) { return d0 * 512 + ks * 4096 + half * 2048; }
template <int OFF> __device__ __forceinline__ s16x4 tr_read(int vb) {
  s16x4 r; asm volatile("ds_read_b64_tr_b16 %0, %1 offset:%2" : "=&v"(r) : "v"(vb), "i"(OFF) : "memory"); return r;
}
template <int D0> __device__ __forceinline__ void pv_one(f32x16& od, int vb, bf16x8 pa0, bf16x8 pa1, bf16x8 pa2, bf16x8 pa3) {
  const s16x4 l0 = tr_read<v_rd_off(D0, 0, 0)>(vb), h0 = tr_read<v_rd_off(D0, 0, 1)>(vb), l1 = tr_read<v_rd_off(D0, 1, 0)>(vb), h1 = tr_read<v_rd_off(D0, 1, 1)>(vb);
  const s16x4 l2 = tr_read<v_rd_off(D0, 2, 0)>(vb), h2 = tr_read<v_rd_off(D0, 2, 1)>(vb), l3 = tr_read<v_rd_off(D0, 3, 0)>(vb), h3 = tr_read<v_rd_off(D0, 3, 1)>(vb);
  asm volatile("s_waitcnt lgkmcnt(0)" ::: "memory"); SBAR();
#define PK(L, H) (bf16x8){L[0], L[1], L[2], L[3], H[0], H[1], H[2], H[3]}
  od = __builtin_amdgcn_mfma_f32_32x32x16_bf16(pa0, PK(l0, h0), od, 0, 0, 0);
  od = __builtin_amdgcn_mfma_f32_32x32x16_bf16(pa1, PK(l1, h1), od, 0, 0, 0);
  od = __builtin_amdgcn_mfma_f32_32x32x16_bf16(pa2, PK(l2, h2), od, 0, 0, 0);
  od = __builtin_amdgcn_mfma_f32_32x32x16_bf16(pa3, PK(l3, h3), od, 0, 0, 0);
#undef PK
}
__device__ __forceinline__ void pv_d0(f32x16* o, int vb, bf16x8 pa0, bf16x8 pa1, bf16x8 pa2, bf16x8 pa3) {
  pv_one<0>(o[0], vb, pa0, pa1, pa2, pa3); pv_one<1>(o[1], vb, pa0, pa1, pa2, pa3); pv_one<2>(o[2], vb, pa0, pa1, pa2, pa3); pv_one<3>(o[3], vb, pa0, pa1, pa2, pa3);
}

__device__ __forceinline__ void attn_body(const u16* __restrict__ Qb, const u16* __restrict__ Kh, const u16* __restrict__ Vh, u16* Ob, const u16* __restrict__ Gb, char* lds) {
  const int tid = ltid(), wid = tid >> 6, lane = tid & 63, r32 = lane & 31, hi = lane >> 5;
  char* V_lds = lds; char* K_lds = lds + 2 * SHM_V;
  float* ws = (float*)(lds + 2 * SHM_V + 2 * SHM_K) + wid * 64; float* li_l = ws; float* al_l = ws + 32;
  float m_reg = -1e30f, l_reg = 0; f32x16 o[4] = {}; bf16x8 qr[8];
  const u16* Qw = Qb + (long)(wid * QBLK + r32) * LDQ + hi * 8;
#pragma unroll
  for (int d0 = 0; d0 < 8; ++d0) qr[d0] = *reinterpret_cast<const bf16x8*>(Qw + d0 * 16);
  const int sr = tid >> 4, sc = (tid & 15) * 8, vst0 = v_st(sr, sc), vst1 = v_st(32 + sr, sc);
  const int vb0 = (int)(uintptr_t)V_lds + v_rd_base(lane);
  bf16x8 e_vs0, e_vs1, e_ks0, e_ks1, o_vs0, o_vs1, o_ks0, o_ks1;
#define SLOAD_E(k0) do { e_vs0 = *(const bf16x8*)&Vh[(long)((k0) + sr) * LDK + sc]; e_vs1 = *(const bf16x8*)&Vh[(long)((k0) + 32 + sr) * LDK + sc]; \
    e_ks0 = *(const bf16x8*)&Kh[(long)((k0) + sr) * LDK + sc]; e_ks1 = *(const bf16x8*)&Kh[(long)((k0) + 32 + sr) * LDK + sc]; } while (0)
#define SLOAD_O(k0) do { o_vs0 = *(const bf16x8*)&Vh[(long)((k0) + sr) * LDK + sc]; o_vs1 = *(const bf16x8*)&Vh[(long)((k0) + 32 + sr) * LDK + sc]; \
    o_ks0 = *(const bf16x8*)&Kh[(long)((k0) + sr) * LDK + sc]; o_ks1 = *(const bf16x8*)&Kh[(long)((k0) + 32 + sr) * LDK + sc]; } while (0)
#define SWRITE(b, P) do { *(bf16x8*)(V_lds + (b) * SHM_V + vst0) = P##_vs0; *(bf16x8*)(V_lds + (b) * SHM_V + vst1) = P##_vs1; const int kc = sc * 2; \
    *(bf16x8*)(K_lds + (b) * SHM_K + KSWZ(sr, kc)) = P##_ks0; *(bf16x8*)(K_lds + (b) * SHM_K + KSWZ(32 + sr, kc)) = P##_ks1; } while (0)
#define SWAIT() asm volatile("s_waitcnt vmcnt(4)" ::: "memory")
#define RESC(a) do { if (__any((a) < 1.f)) { if (hi == 0) al_l[r32] = (a); asm volatile("s_waitcnt lgkmcnt(0)" ::: "memory"); \
    _Pragma("unroll") for (int d = 0; d < 4; ++d) _Pragma("unroll") for (int r = 0; r < 16; ++r) o[d][r] *= al_l[crow(r, hi)]; } } while (0)
  f32x16 pA0, pA1, pB0, pB1; float mnA, mnB, alA, alB; bf16x8 pa0, pa1, pa2, pa3;
#define ITER(J, MB, MA, LOADE) do { \
    SBAR(); qkt(pB0, pB1, K_lds + SHM_K, qr, r32, hi); \
    finishSM(pA0, pA1, alA, l_reg, pa0, pa1, pa2, pa3); SBAR(); \
    SLOAD_O(((J) + 2) * KVBLK); SBAR(); \
    pv_d0(o, vb0, pa0, pa1, pa2, pa3); partialSM<MB>(pB0, pB1, m_reg, mnB, alB); \
    __syncthreads(); SWAIT(); SWRITE(0, e); \
    RESC(alB); __syncthreads(); \
    SBAR(); qkt(pA0, pA1, K_lds, qr, r32, hi); \
    finishSM(pB0, pB1, alB, l_reg, pa0, pa1, pa2, pa3); SBAR(); \
    if (LOADE) SLOAD_E(((J) + 3) * KVBLK); SBAR(); \
    pv_d0(o, vb0 + (int)SHM_V, pa0, pa1, pa2, pa3); partialSM<MA>(pA0, pA1, m_reg, mnA, alA); \
    __syncthreads(); SWAIT(); SWRITE(1, o); \
    RESC(alA); __syncthreads(); } while (0)
  SLOAD_E(0); asm volatile("s_waitcnt vmcnt(0)" ::: "memory"); SWRITE(0, e); __syncthreads();
  qkt(pA0, pA1, K_lds, qr, r32, hi); partialSM<0>(pA0, pA1, m_reg, mnA, alA);
  SLOAD_O(KVBLK); SLOAD_E(2 * KVBLK);
  SWAIT(); SWRITE(1, o); __syncthreads();
#pragma unroll 1
  for (int j = 1; j < NT - 3; j += 2) ITER(j, 0, 0, 1);
  ITER(NT - 3, 0, 1, 0);
  SBAR(); qkt(pB0, pB1, K_lds + SHM_K, qr, r32, hi);
  finishSM(pA0, pA1, alA, l_reg, pa0, pa1, pa2, pa3); SBAR();
  pv_d0(o, vb0, pa0, pa1, pa2, pa3); partialSM<2>(pB0, pB1, m_reg, mnB, alB);
  __syncthreads(); RESC(alB);
  finishSM(pB0, pB1, alB, l_reg, pa0, pa1, pa2, pa3); SBAR();
  pv_d0(o, vb0 + (int)SHM_V, pa0, pa1, pa2, pa3);
  __syncthreads();
  if (hi == 0) li_l[r32] = l_reg; asm volatile("s_waitcnt lgkmcnt(0)" ::: "memory");
  { char* Ow = lds + wid * 8192;
#pragma unroll
    for (int r = 0; r < 16; ++r) { const int orow = crow(r, hi); const float rl = __builtin_amdgcn_rcpf(li_l[orow]);
#pragma unroll
      for (int d0 = 0; d0 < 4; ++d0) *(u16*)(Ow + orow * 256 + (d0 * 32 + r32) * 2) = f2bf(o[d0][r] * rl); }
    asm volatile("s_waitcnt lgkmcnt(0)" ::: "memory");
#pragma unroll
    for (int i = 0; i < 8; ++i) { const int id = i * 64 + lane, row = id >> 4, ch = id & 15;
      const u32x4 ov = *(const u32x4*)(Ow + row * 256 + ch * 16); const long gi = (long)(wid * QBLK + row) * LDO + ch * 8; const u32x4 g = *(const u32x4*)(Gb + gi);
      u32x4 w; w.x = cvtpk(bflo(ov.x) * silu_f(bflo(g.x)), bfhi(ov.x) * silu_f(bfhi(g.x))); w.y = cvtpk(bflo(ov.y) * silu_f(bflo(g.y)), bfhi(ov.y) * silu_f(bfhi(g.y)));
      w.z = cvtpk(bflo(ov.z) * silu_f(bflo(g.z)), bfhi(ov.z) * silu_f(bfhi(g.z))); w.w = cvtpk(bflo(ov.w) * silu_f(bflo(g.w)), bfhi(ov.w) * silu_f(bfhi(g.w)));
      *(u32x4*)(Ob + gi) = w; } }
  __syncthreads();
#undef ITER
#undef SLOAD_E
#undef SLOAD_O
#undef SWRITE
#undef SWAIT
#undef RESC
}
}
__device__ __forceinline__ float block_reduce(float v, float* red, bool is_max) {
  const int tl = ltid(), lane = tl & 63, wid = tl >> 6;
  for (int o = 32; o > 0; o >>= 1) { const float t = __shfl_xor(v, o); v = is_max ? fmaxf(v, t) : v + t; }
  __syncthreads();
  if (lane == 0) red[wid] = v;
  __syncthreads();
  float r = red[0];
  for (int i = 1; i < 8; ++i) r = is_max ? fmaxf(r, red[i]) : r + red[i];
  return r;
}
__device__ void meta_attn(int pair, u16* qb, const u16* kb, const u16* vb, const u16* ag, char* lds) {
  const int tid = ltid(), lane = tid & 63, wid = tid >> 6, h = pair >> 4, r = pair & 15, kvh = h >> 2;
  float* qs = (float*)lds; float* sc = qs + 128; float* red = sc + 16512; float* part = red + 16;
  u16* qrow = qb + (size_t)r * 1024 + h * 128;
  if (tid < 128) qs[tid] = bf2f(qrow[tid]);
  __syncthreads();
  float lmax = -1e30f;
  for (int key = tid; key < ST; key += 512) {
    const bf16x8* kp = (const bf16x8*)(kb + (size_t)key * 256 + kvh * 128); float d = 0.f;
#pragma unroll
    for (int c = 0; c < 16; ++c) { const bf16x8 kv = kp[c];
#pragma unroll
      for (int e = 0; e < 8; ++e) d += bf2f((u16)kv[e]) * qs[c * 8 + e]; }
    d *= att::SCALE; sc[key] = d; lmax = fmaxf(lmax, d);
  }
  const float gmax = block_reduce(lmax, red, true);
  float lsum = 0.f;
  for (int key = tid; key < ST; key += 512) { const float e = __expf(sc[key] - gmax); sc[key] = e; lsum += e; }
  const float gsum = block_reduce(lsum, red, false);
  __syncthreads();
  const int dc = tid & 15, pt = tid >> 4;
  float acc[8];
#pragma unroll
  for (int e = 0; e < 8; ++e) acc[e] = 0.f;
#pragma unroll 4
  for (int key = pt; key < ST; key += 32) {
    const bf16x8 v = *(const bf16x8*)(vb + (size_t)key * 256 + kvh * 128 + dc * 8); const float pk = sc[key];
#pragma unroll
    for (int e = 0; e < 8; ++e) acc[e] += pk * bf2f((u16)v[e]);
  }
#pragma unroll
  for (int e = 0; e < 8; ++e) part[pt * 128 + dc * 8 + e] = acc[e];
  __syncthreads();
  if (tid < 128) { float o = 0.f; for (int pp = 0; pp < 32; ++pp) o += part[pp * 128 + tid];
    const float g = bf2f(ag[(size_t)r * 1024 + h * 128 + tid]); qrow[tid] = f2bf(o / gsum * silu_f(g)); }
  __syncthreads();
}

template <class F> __device__ __forceinline__ void meta_gemm(const u16* A, const u16* Bt, int N, int K, int gw, int nw, F epi) {
  const int lane = ltid() & 63;
  for (int tile = gw; tile < N / 16; tile += nw) {
    f32x4 acc = {0.f, 0.f, 0.f, 0.f};
    const u16* ap = A + (size_t)(lane & 15) * K + 8 * (lane >> 4); const u16* bp = Bt + (size_t)(tile * 16 + (lane & 15)) * K + 8 * (lane >> 4);
    for (int k0 = 0; k0 < K; k0 += 32) acc = __builtin_amdgcn_mfma_f32_16x16x32_bf16(*(const bf16x8*)(ap + k0), *(const bf16x8*)(bp + k0), acc, 0, 0, 0);
    epi(tile * 16 + (lane & 15), (lane >> 4) * 4, acc);
  }
}
__device__ __forceinline__ float meta_rstd(const float* hmeta) {
  const int lane = ltid() & 63; const f32x4* hp = (const f32x4*)(hmeta + (size_t)(lane & 15) * 1024 + (lane >> 4) * 256); float ss = 0.f;
  for (int i = 0; i < 64; ++i) { const f32x4 v = hp[i]; ss += v[0] * v[0] + v[1] * v[1] + v[2] * v[2] + v[3] * v[3]; }
  ss += __shfl_xor(ss, 16); ss += __shfl_xor(ss, 32);
  return rsqrtf(ss * (1.f / 1024.f) + EPS);
}
__device__ __forceinline__ int win_src_col(int np) {
  return np < 1024 ? np : (np < 1536 ? np + 1024 : (np < 2560 ? np - 512 : np));
}
template <int K8> __device__ __forceinline__ void transpose_w(const float* src, u16* dst, int N, const float* scale, size_t gt, size_t gs) {
  for (size_t it = gt; it < (size_t)K8 * N; it += gs) {
    const int n = (int)(it % N), kb = (int)(it / N);
    const float* s = src + (size_t)kb * 8 * N + n; float v[8];
#pragma unroll
    for (int i = 0; i < 8; ++i) v[i] = s[(size_t)i * N] * (scale ? scale[kb * 8 + i] : 1.f);
    u32x4 w; w.x = cvtpk(v[0], v[1]); w.y = cvtpk(v[2], v[3]); w.z = cvtpk(v[4], v[5]); w.w = cvtpk(v[6], v[7]);
    *(u32x4*)(dst + (size_t)n * (K8 * 8) + kb * 8) = w;
  }
}
__device__ void prep_phase(const Params& p, char* lds) {
  const int tl = ltid(); const size_t gt = (size_t)blockIdx.x * 512 + tl, gs = (size_t)gridDim.x * 512;
  unsigned char* ws = p.ws;
  float* tab = (float*)lds;
  if (tl < 128) { float s, c; sincospif((float)tl / 64.f, &s, &c); tab[tl] = c; tab[128 + tl] = s; }
  __syncthreads();
  for (int l = 0; l < 2; ++l) {
    { u16* dst = (u16*)(ws + OFF_WIN + l * SZ_WIN); const float* src = p.w_in + (size_t)l * DM * INW; const float* g = p.norm_g + l * DM;
      for (size_t it = gt; it < (size_t)128 * INW; it += gs) {
        const int np = (int)(it % INW), kb = (int)(it / INW), n = win_src_col(np);
        const float* s = src + (size_t)kb * 8 * INW + n; float v[8];
#pragma unroll
        for (int i = 0; i < 8; ++i) v[i] = s[(size_t)i * INW] * g[kb * 8 + i];
        u32x4 w; w.x = cvtpk(v[0], v[1]); w.y = cvtpk(v[2], v[3]); w.z = cvtpk(v[4], v[5]); w.w = cvtpk(v[6], v[7]);
        *(u32x4*)(dst + (size_t)np * DM + kb * 8) = w;
      } }
    transpose_w<64>(p.w_fproj + (size_t)l * 512 * 1024, (u16*)(ws + OFF_WFP + l * SZ_WFP), 1024, nullptr, gt, gs);
    transpose_w<128>(p.w_aproj + (size_t)l * 1024 * 1024, (u16*)(ws + OFF_WAP + l * SZ_W1K), 1024, nullptr, gt, gs);
    transpose_w<128>(p.w_out + (size_t)l * 1024 * 1024, (u16*)(ws + OFF_WOUT + l * SZ_W1K), 1024, nullptr, gt, gs);
    { u16* dst = (u16*)(ws + OFF_MMIX + l * SZ_MMIX); const float* wm = p.w_fmix + (size_t)l * 4 * 128 * 128;
      for (size_t it = gt; it < (size_t)4 * 2 * 128 * 128; it += gs) {
        const int d = (int)(it & 127), c = (int)((it >> 7) & 127), ri = (int)((it >> 14) & 1), g = (int)(it >> 15);
        const float* wp = wm + (size_t)g * 16384 + d; const float* tb = tab + ri * 128; float a = 0.f;
        for (int cp = 0; cp < 128; ++cp) a += tb[(c * cp) & 127] * wp[(size_t)cp * 128];
        dst[(size_t)(g * 128 + d) * 1024 + g * 256 + ri * 128 + c] = f2bf(a * 0.08838834764831845f);
      }
      for (size_t it = gt; it < (size_t)512 * 128; it += gs) {
        const int n = (int)(it >> 7), kc = (int)(it & 127);
        if ((kc >> 5) != (n >> 7)) { u32x4 z = {0u, 0u, 0u, 0u}; *(u32x4*)(dst + (size_t)n * 1024 + kc * 8) = z; }
      } }
  }
  { u16* dst = (u16*)(ws + OFF_F1T);
    for (size_t it = gt; it < (size_t)512 * 256; it += gs) {
      const int col = (int)(it & 255), row = (int)(it >> 8), k1 = (row >> 8) * 128 + (row & 127), ri = (row >> 7) & 1; float v = 0.f;
      if (k1 < FN1 && col < FN1) { float s, c; sincospif((float)(2 * ((k1 * col) % FN1)) / (float)FN1, &s, &c); v = (ri ? -s : c) * 0.07808688094430304f; }
      dst[it] = f2bf(v);
    } }
  { u16* dst = (u16*)(ws + OFF_F2T);
    for (size_t it = gt; it < (size_t)256 * 256; it += gs) {
      const int col = (int)(it & 255), row = (int)(it >> 8), k2 = row & 127, s2 = col & 127, ro = row >> 7, ri = col >> 7; float v = 0.f;
      if (k2 < FN2 && s2 < FN2) { float s, c; sincospif((float)(2 * ((k2 * s2) % FN2)) / (float)FN2, &s, &c); v = (ro == ri ? c : (ro == 0 ? s : -s)) * 0.1f; }
      dst[it] = f2bf(v);
    } }
  { float* tw = (float*)(ws + OFF_TW);
    for (size_t it = gt; it < (size_t)FN1 * FN2; it += gs) { const int s2 = (int)(it % FN2), k1 = (int)(it / FN2); float s, c; sincospif((float)(2 * k1 * s2) / (float)ST, &s, &c); tw[it * 2] = c; tw[it * 2 + 1] = -s; } }
  { float* cs = (float*)(ws + OFF_CS);
    for (size_t it = gt; it < (size_t)256 * 32; it += gs) { const int j = (int)(it & 31), pos = (int)(it >> 5); const float inv = powf(10000.f, -(float)(2 * j) / 64.f); const float ang = (float)pos * inv; cs[it * 2] = cosf(ang); cs[it * 2 + 1] = sinf(ang); } }
  { u32x4* kz = (u32x4*)(ws + OFF_K + (size_t)ST * 512); u32x4* vz = (u32x4*)(ws + OFF_V + (size_t)ST * 512); const u32x4 z = {0u, 0u, 0u, 0u};
    for (size_t it = gt; it < (size_t)(TPAD - ST) * 32; it += gs) { kz[it] = z; vz[it] = z; } }
  { const int lane = tl & 63, gw = blockIdx.x * 8 + (tl >> 6), nw = gridDim.x * 8;
    u16* hb = (u16*)(ws + OFF_HB); float* rstd = (float*)(ws + OFF_RSTD); float* hm = (float*)(ws + OFF_HMETA);
    for (int s = gw; s < ST; s += nw) {
      const float* src = s < 16 ? p.meta + (size_t)s * 1024 : p.x + (size_t)(s - 16) * 1024; float ss = 0.f;
#pragma unroll
      for (int i = 0; i < 4; ++i) { const f32x4 v = *(const f32x4*)(src + i * 256 + lane * 4); ss += v[0] * v[0] + v[1] * v[1] + v[2] * v[2] + v[3] * v[3];
        u32x2 w; w.x = cvtpk(v[0], v[1]); w.y = cvtpk(v[2], v[3]); *(u32x2*)(hb + (size_t)s * 1024 + i * 256 + lane * 4) = w;
        if (s < 16) *(f32x4*)(hm + (size_t)s * 1024 + i * 256 + lane * 4) = v; }
      ss = wave_sum(ss);
      if (lane == 0) rstd[s] = rsqrtf(ss * (1.f / 1024.f) + EPS);
    } }
}
template <class Epi> __device__ __forceinline__ void run_gemm(PG8_LAS unsigned char* lds, const u16* A, const u16* Bt, int M, int N, int K, int rot, const Epi& E) {
  asm volatile("" : "+s"(K)); asm volatile("" : "+s"(N)); asm volatile("" : "+s"(M));
  pg8::StaticOrder S; S.init(M, N, (int)gridDim.x, (int)((blockIdx.x + rot) % gridDim.x));
  pg8::gemm_phase<Epi, pg8::StaticOrder, false>(lds, pg8::Gemm{A, Bt, M, N, K}, S, E, nullptr);
}

__global__ __launch_bounds__(512, 2) void fwd_megakernel(Params p) {
  extern __shared__ __attribute__((aligned(16))) unsigned char shm[];
  cg::grid_group grid = cg::this_grid();
  PG8_LAS unsigned char* lds3 = (PG8_LAS unsigned char*)shm; char* lds = (char*)shm;
  unsigned char* ws = p.ws;
  const int nw = gridDim.x * 8;
  u16* hb = (u16*)(ws + OFF_HB); float* ssqp = (float*)(ws + OFF_SSQ); float* rstd = (float*)(ws + OFF_RSTD); float* hmeta = (float*)(ws + OFF_HMETA);
  u16* tb = (u16*)(ws + OFF_T); u16* kb = (u16*)(ws + OFF_K); u16* vb = (u16*)(ws + OFF_V);
  u16* qb = (u16*)(ws + OFF_Q); u16* ag = (u16*)(ws + OFF_AG); u16* mb = ag; u16* gt = (u16*)(ws + OFF_GT);
  u16* ut = (u16*)(ws + OFF_UT); u16* yt = (u16*)(ws + OFF_YT); u16* wb = (u16*)(ws + OFF_WB); u16* fg = (u16*)(ws + OFF_FG);
  const u16* f1t = (const u16*)(ws + OFF_F1T); const u16* f2t = (const u16*)(ws + OFF_F2T); const float* tw = (const float*)(ws + OFF_TW); const float* cs = (const float*)(ws + OFF_CS);

  prep_phase(p, lds);
  grid.sync();

  for (int l = 0; l < 2; ++l) {
#define IDS() const int tid = ltid(), lane = tid & 63, wid = tid >> 6, gw = blockIdx.x * 8 + wid; (void)lane; (void)wid; (void)gw
    const u16* winT = (const u16*)(ws + OFF_WIN + l * SZ_WIN); const u16* wfpT = (const u16*)(ws + OFF_WFP + l * SZ_WFP);
    const u16* wapT = (const u16*)(ws + OFF_WAP + l * SZ_W1K); const u16* woT = (const u16*)(ws + OFF_WOUT + l * SZ_W1K); const u16* mmT = (const u16*)(ws + OFF_MMIX + l * SZ_MMIX);
    const float* bg = p.b_gate + l * 2048; const float* qg = p.q_g + l * 128; const float* kg = p.k_g + l * 128;

    { IDS(); EpiA E{rstd, ut, fg, kb, vb};
      run_gemm(lds3, hb + 16 * 1024, winT, SEQ, 1536, 1024, 0, E);
      if (gw < 1536 / 16) { const float rs = meta_rstd(hmeta);
        meta_gemm(hb, winT, 1536, 1024, gw, nw, [&](int col, int r0, f32x4 acc) {
#pragma unroll
          for (int j = 0; j < 4; ++j) { const int s = r0 + j; const u16 v = f2bf(acc[j] * __shfl(rs, s));
            if (col < 512) ut[((size_t)col * FN2 + s) * 256] = v; else if (col < 1024) fg[(size_t)s * 512 + col - 512] = v;
            else if (col < 1280) kb[(size_t)s * 256 + col - 1024] = v; else vb[(size_t)s * 256 + col - 1280] = v; } }); } }
    grid.sync();
    { IDS(); EpiF1 E{tw, yt};
      run_gemm(lds3, f1t, ut, 512, 512 * FN2, 256, 0, E);
      for (int idx = gw; idx < ST * 2; idx += nw) fix_row(kb + (size_t)(idx >> 1) * 256 + (idx & 1) * 128, kg, idx >> 1, cs, lane); }
    grid.sync();
    { IDS(); EpiF2 E{wb}; run_gemm(lds3, f2t, yt, 256, FN1 * 512, 256, 0, E); }
    grid.sync();
    { IDS(); EpiMix E{fg, tb};
      run_gemm(lds3, wb + 16 * 1024, mmT, SEQ, 512, 1024, 0, E);
      meta_gemm(wb, mmT, 512, 1024, (gw + nw - 1024) % nw, nw, [&](int col, int r0, f32x4 acc) {
#pragma unroll
        for (int j = 0; j < 4; ++j) { const int s = r0 + j; tb[(size_t)s * 512 + col] = f2bf(acc[j] * silu_f(bf2f(fg[(size_t)s * 512 + col]))); } }); }
    grid.sync();
    { IDS(); EpiE E{rstd, bg, qb, ag, gt};
      run_gemm(lds3, hb + 16 * 1024, winT + (size_t)1536 * 1024, SEQ, 4096, 1024, 0, E);
      if (gw < 4096 / 16) { const float rs = meta_rstd(hmeta);
        meta_gemm(hb, winT + (size_t)1536 * 1024, 4096, 1024, gw, nw, [&](int col, int r0, f32x4 acc) {
#pragma unroll
          for (int j = 0; j < 4; ++j) { const int s = r0 + j; const float v = acc[j] * __shfl(rs, s);
            if (col < 1024) qb[(size_t)s * 1024 + col] = f2bf(v); else if (col < 2048) ag[(size_t)s * 1024 + col - 1024] = f2bf(v);
            else gt[(size_t)s * 2048 + col - 2048] = f2bf(sigm_f(v + bg[col - 2048])); } }); } }
    grid.sync();
    { IDS(); for (int idx = gw; idx < ST * 8; idx += nw) fix_row(qb + (size_t)(idx >> 3) * 1024 + (idx & 7) * 128, qg, idx >> 3, cs, lane);
      grid.sync();
      for (int pair = blockIdx.x; pair < 128; pair += gridDim.x) meta_attn(pair, qb, kb, vb, ag, lds);
      for (int item = blockIdx.x; item < 512; item += gridDim.x) {
        const int h = item >> 6, blk = item & 63, s0 = 16 + blk * 256;
        u16* Qb = qb + (size_t)s0 * 1024 + h * 128;
        att::attn_body(Qb, kb + (h >> 2) * 128, vb + (h >> 2) * 128, Qb, ag + (size_t)s0 * 1024 + h * 128, lds);
      } }
    grid.sync();
    { IDS(); EpiG<0> E0{gt, mb}; run_gemm(lds3, tb + 16 * 512, wfpT, SEQ, 1024, 512, 0, E0);
      EpiG<1> E1{gt, mb}; run_gemm(lds3, qb + 16 * 1024, wapT, SEQ, 1024, 1024, 0, E1);
      for (int tile = gw; tile < 64; tile += nw) {
        f32x4 a1 = {0.f, 0.f, 0.f, 0.f}, a2 = {0.f, 0.f, 0.f, 0.f}; const int col = tile * 16 + (lane & 15), r0 = (lane >> 4) * 4;
        { const u16* ap = tb + (size_t)(lane & 15) * 512 + 8 * (lane >> 4); const u16* bp = wfpT + (size_t)col * 512 + 8 * (lane >> 4);
          for (int k0 = 0; k0 < 512; k0 += 32) a1 = __builtin_amdgcn_mfma_f32_16x16x32_bf16(*(const bf16x8*)(ap + k0), *(const bf16x8*)(bp + k0), a1, 0, 0, 0); }
        { const u16* ap = qb + (size_t)(lane & 15) * 1024 + 8 * (lane >> 4); const u16* bp = wapT + (size_t)col * 1024 + 8 * (lane >> 4);
          for (int k0 = 0; k0 < 1024; k0 += 32) a2 = __builtin_amdgcn_mfma_f32_16x16x32_bf16(*(const bf16x8*)(ap + k0), *(const bf16x8*)(bp + k0), a2, 0, 0, 0); }
#pragma unroll
        for (int j = 0; j < 4; ++j) { const int s = r0 + j; mb[(size_t)s * 1024 + col] = f2bf(bf2f(gt[(size_t)s * 2048 + col]) * a1[j] + bf2f(gt[(size_t)s * 2048 + 1024 + col]) * a2[j]); }
      } }
    grid.sync();
    { IDS(); EpiH E{l == 0 ? p.x : p.out, p.out, hb, ssqp};
      run_gemm(lds3, mb + 16 * 1024, woT, SEQ, 1024, 1024, 0, E);
      meta_gemm(mb, woT, 1024, 1024, gw, nw, [&](int col, int r0, f32x4 acc) {
#pragma unroll
        for (int j = 0; j < 4; ++j) { const int s = r0 + j; const float v = hmeta[(size_t)s * 1024 + col] + acc[j]; hmeta[(size_t)s * 1024 + col] = v; hb[(size_t)s * 1024 + col] = f2bf(v); } }); }
    if (l == 0) { grid.sync(); IDS();
      for (int s = 16 + blockIdx.x * 512 + tid; s < ST; s += gridDim.x * 512) rstd[s] = rstd_from_ssqp(ssqp + (size_t)s * 16);
      grid.sync(); }
  }
}

extern "C" void kernel_launch(void* const* d_in, const int* in_sizes, int n_in, void* d_out, int out_size, void* d_ws, size_t ws_size, hipStream_t stream) {
  static int grid_blocks = 0;
  if (grid_blocks == 0) {
    if (n_in != 11 || out_size != SEQ * DM || ws_size < OFF_XEND) { fprintf(stderr, "kernel_launch: unexpected shapes (n_in %d out %d ws %zu, need ws >= %zu)\n", n_in, out_size, ws_size, (size_t)OFF_XEND); grid_blocks = -1; return; }
    int dev = 0, cus = 0, per_cu = 0;
    (void)hipGetDevice(&dev); (void)hipDeviceGetAttribute(&cus, hipDeviceAttributeMultiprocessorCount, dev);
    if (hipFuncSetAttribute((const void*)fwd_megakernel, hipFuncAttributeMaxDynamicSharedMemorySize, LDS_BYTES) != hipSuccess) { fprintf(stderr, "kernel_launch: hipFuncSetAttribute failed\n"); grid_blocks = -1; return; }
    if (hipOccupancyMaxActiveBlocksPerMultiprocessor(&per_cu, (const void*)fwd_megakernel, 512, LDS_BYTES) != hipSuccess || per_cu < 1) { fprintf(stderr, "kernel_launch: occupancy query says %d blocks per CU\n", per_cu); (void)hipGetLastError(); per_cu = 1; }
    grid_blocks = cus * 1;
    fprintf(stderr, "kernel_launch: grid %d (cus %d, per_cu %d), ws %zu, need %zu\n", grid_blocks, cus, per_cu, ws_size, (size_t)OFF_XEND);
  }
  if (grid_blocks < 0) return;
  Params p{};
  p.x = (const float*)d_in[0]; p.meta = (const float*)d_in[1]; p.norm_g = (const float*)d_in[2]; p.w_in = (const float*)d_in[3]; p.b_gate = (const float*)d_in[4];
  p.q_g = (const float*)d_in[5]; p.k_g = (const float*)d_in[6]; p.w_fmix = (const float*)d_in[7]; p.w_fproj = (const float*)d_in[8]; p.w_aproj = (const float*)d_in[9]; p.w_out = (const float*)d_in[10];
  p.out = (float*)d_out; p.ws = (unsigned char*)d_ws;
  void* args[] = {&p};
  const hipError_t e = hipLaunchCooperativeKernel((const void*)fwd_megakernel, dim3(grid_blocks), dim3(512), args, LDS_BYTES, stream);
  if (e != hipSuccess) fprintf(stderr, "kernel_launch: cooperative launch failed: %s (grid %d)\n", hipGetErrorString(e), grid_blocks);
}
```

```cpp
#include <hip/hip_runtime.h>
#include <hip/hip_bf16.h>
#include <hip/hip_cooperative_groups.h>
#include <cstdio>
namespace cg = cooperative_groups;
namespace pg8 {
#define PG8_LAS __attribute__((address_space(3)))
typedef unsigned short bf16_t;
typedef short bf16x8 __attribute__((ext_vector_type(8)));
typedef float f32x4 __attribute__((ext_vector_type(4)));
typedef unsigned u32x4 __attribute__((ext_vector_type(4)));
constexpr int BM = 256, BK = 64, HALF = 128, HTB = HALF * BK * 2  , STAGE_BYTES = 8 * HTB, NXCD = 8, WGM = 8;

__host__ __device__ __forceinline__ int lds_byte(int r, int c) { const int st = (r >> 4) * 2 + (c >> 5), rr = r & 15, cc = c & 31, ob = rr * 64 + cc * 2; return st * 1024 + (ob ^ (((ob >> 9) & 1) << 5)); }
__host__ __device__ __forceinline__ void stage_rc(int b, int& R, int& C) { const int st = b / 1024, sb = b % 1024, swz = sb ^ (((sb >> 9) & 1) << 5); R = (st >> 1) * 16 + swz / 64; C = (st & 1) * 32 + (swz % 64) / 2; }
__host__ __device__ __forceinline__ int perm32(int rho) { const int n = rho >> 4, i = rho & 15; return 8 * (i >> 2) + 4 * n + (i & 3); }

struct Unit { int pm, pn; };
struct Gemm { const bf16_t* A; const bf16_t* Bt; int M, N, K; int lda; };

struct StaticOrder {
    int nM, nN, nwg, G, c;
    __host__ __device__ void init(int M, int N, int G_, int c_) { nM = M / BM; nN = N / BM; nwg = nM * nN; G = G_; c = c_; }
    __host__ __device__ bool next(int i, Unit& u) const {
        const long L = (long)i * G + c; if (L >= nwg) return false;
        int wgid = (int)L; { const int q = nwg / NXCD, r = nwg % NXCD, xcd = wgid % NXCD, off = wgid / NXCD; wgid = (xcd < r ? xcd * (q + 1) : r * (q + 1) + (xcd - r) * q) + off; }
        const int nig = WGM * nN, gid = wgid / nig, fm = gid * WGM, gsz = (nM - fm) < WGM ? (nM - fm) : WGM;
        u.pm = fm + ((wgid % nig) % gsz); u.pn = (wgid % nig) / gsz; return true;
    }
    __device__ __forceinline__ void a_ready(const Unit&) const {}
    __device__ __forceinline__ void done(const Unit&) const {}
};
template <class Epi, class Sched, bool STAMP = false>
__device__ __forceinline__ void gemm_phase(PG8_LAS unsigned char* lds, const Gemm g, const Sched& S, const Epi& E, unsigned long long* stamps) {
    int tid_l = threadIdx.x; asm volatile("" : "+v"(tid_l));
    const int tid = tid_l, wid = __builtin_amdgcn_readfirstlane(tid >> 6), lane = tid & 63, wr = wid >> 2, wc = wid & 3, fr = lane & 15, fq = lane >> 4;
    const int K = g.K, nt = K / BK, lda = g.lda ? g.lda : K;
    int ts_lo = 0, ts_hi = 0, nts = 0; const unsigned long long rt_entry = STAMP ? (unsigned long long)wall_clock64() : 0ull;
#define PG8_STAMP() do { if (STAMP && wid == 0 && nts < 64) { const unsigned long long _c = (unsigned long long)clock64(); \
        ts_lo = (lane == nts) ? (int)(unsigned)_c : ts_lo; ts_hi = (lane == nts) ? (int)(unsigned)(_c >> 32) : ts_hi; ++nts; } } while (0)
    PG8_STAMP();
    unsigned voffA[2], voffB[2];
#pragma unroll
    for (int i = 0; i < 2; ++i) { int R, C; stage_rc(tid * 16 + i * 8192, R, C); const int Rb = Epi::PERM ? ((R & ~31) + perm32(R & 31)) : R;
        voffA[i] = (unsigned)(R * lda + C) * 2u; voffB[i] = (unsigned)(Rb * K + C) * 2u; }
    const size_t kstep = (size_t)(BK * 2);
    const size_t hstep = (size_t)HALF * K * 2;
    const size_t tstep = 2 * hstep;
    const size_t hstepA = (size_t)HALF * lda * 2, tstepA = 2 * hstepA;
    const unsigned ldsw = (unsigned)wid * 1024u;
    const int aoff = lds_byte(wr * 64 + fr, fq * 8), boff = lds_byte(wc * 32 + fr, fq * 8);
#define PG8_SA(b, h) (((b) * 2 + (h)) * HTB)
#define PG8_SB(b, h) ((4 + (b) * 2 + (h)) * HTB)
#define PG8_STAGE(bufoff, gbase, voff) do { _Pragma("unroll") for (int _i = 0; _i < 2; ++_i) \
        __builtin_amdgcn_global_load_lds((const unsigned*)((const char*)(gbase) + (voff)[_i]), (PG8_LAS unsigned*)(lds + (bufoff) + ldsw + _i * 8192), 16, 0, 0); } while (0)
#define PG8_LDA(dst, b, h) do { _Pragma("unroll") for (int m = 0; m < 4; ++m) _Pragma("unroll") for (int k = 0; k < 2; ++k) dst[m][k] = *(const PG8_LAS bf16x8*)(lds + PG8_SA(b, h) + aoff + m * 2048 + k * 1024); } while (0)
#define PG8_LDB(dst, b, h) do { _Pragma("unroll") for (int n = 0; n < 2; ++n) _Pragma("unroll") for (int k = 0; k < 2; ++k) dst[n][k] = *(const PG8_LAS bf16x8*)(lds + PG8_SB(b, h) + boff + n * 2048 + k * 1024); } while (0)
#define PG8_MMA(ai, bj, At, Bt) do { __builtin_amdgcn_s_setprio(1); _Pragma("unroll") for (int m = 0; m < 4; ++m) _Pragma("unroll") for (int n = 0; n < 2; ++n) _Pragma("unroll") for (int k = 0; k < 2; ++k) \
        acc[ai][bj][m][n] = __builtin_amdgcn_mfma_f32_16x16x32_bf16(Bt[n][k], At[m][k], acc[ai][bj][m][n], 0, 0, 0); __builtin_amdgcn_s_setprio(0); } while (0)
#define PG8_WAIT_V(n) asm volatile("s_waitcnt vmcnt(" #n ")" ::: "memory")
#define PG8_WAIT_L(n) asm volatile("s_waitcnt lgkmcnt(" #n ")" ::: "memory")
#define PG8_BAR __builtin_amdgcn_s_barrier()
#define PG8_SCHED __builtin_amdgcn_sched_barrier(0)
    Unit cur, nxt; int ui = 0;
    if (!S.next(0, cur)) return;
    f32x4 acc[2][2][4][2];
#pragma unroll
    for (int a = 0; a < 2; ++a)
#pragma unroll
        for (int b = 0; b < 2; ++b)
#pragma unroll
            for (int m = 0; m < 4; ++m)
#pragma unroll
                for (int n = 0; n < 2; ++n) acc[a][b][m][n] = (f32x4){0.f, 0.f, 0.f, 0.f};
    bf16x8 At[4][2], B0[2][2], B1[2][2];
    const char* cA = (const char*)g.A + (size_t)cur.pm * tstepA; const char* cB = (const char*)g.Bt + (size_t)cur.pn * tstep;
    S.a_ready(cur);
    PG8_STAGE(PG8_SB(0, 0), cB, voffB); PG8_STAGE(PG8_SA(0, 0), cA, voffA); PG8_STAGE(PG8_SB(0, 1), cB + hstep, voffB); PG8_STAGE(PG8_SA(0, 1), cA + hstepA, voffA);
    if (wr == 1) PG8_BAR;
    PG8_WAIT_V(4); PG8_BAR;
    PG8_STAGE(PG8_SB(1, 0), cB + kstep, voffB); PG8_STAGE(PG8_SA(1, 0), cA + kstep, voffA); PG8_STAGE(PG8_SB(1, 1), cB + hstep + kstep, voffB);
    PG8_WAIT_V(6); PG8_BAR;
    PG8_STAMP();
    for (;;) {
        const bool has_next = S.next(ui + 1, nxt);
        const char* nA = has_next ? (const char*)g.A + (size_t)nxt.pm * tstepA : cA; const char* nB = has_next ? (const char*)g.Bt + (size_t)nxt.pn * tstep : cB;
#pragma unroll 1
        for (int t = 0; t < nt; t += 2) {
            const bool last = (t == nt - 2);
            const char* a1 = cA + (size_t)(t + 1) * kstep;
            const char* a2 = last ? nA : cA + (size_t)(t + 2) * kstep; const char* b2 = last ? nB : cB + (size_t)(t + 2) * kstep;
            const char* a3 = a2 + kstep; const char* b3 = b2 + kstep;
            if (last && has_next) S.a_ready(nxt);
            PG8_LDB(B0, 0, 0); PG8_SCHED; PG8_LDA(At, 0, 0); PG8_STAGE(PG8_SA(1, 1), a1 + hstepA, voffA);
            PG8_WAIT_L(8); PG8_BAR; PG8_WAIT_L(0); PG8_MMA(0, 0, At, B0); PG8_BAR; PG8_SCHED;
            PG8_LDB(B1, 0, 1); PG8_STAGE(PG8_SB(0, 0), b2, voffB);
            PG8_BAR; PG8_WAIT_L(0); PG8_MMA(0, 1, At, B1); PG8_BAR;
            PG8_LDA(At, 0, 1); PG8_STAGE(PG8_SA(0, 0), a2, voffA);
            PG8_BAR; PG8_WAIT_L(0); PG8_MMA(1, 0, At, B0); PG8_BAR; PG8_SCHED;
            PG8_STAGE(PG8_SB(0, 1), b2 + hstep, voffB);
            PG8_WAIT_V(6); PG8_BAR; PG8_MMA(1, 1, At, B1); PG8_BAR;
            PG8_LDB(B0, 1, 0); PG8_SCHED; PG8_LDA(At, 1, 0); PG8_STAGE(PG8_SA(0, 1), a2 + hstepA, voffA);
            PG8_WAIT_L(8); PG8_BAR; PG8_WAIT_L(0); PG8_MMA(0, 0, At, B0); PG8_BAR; PG8_SCHED;
            PG8_LDB(B1, 1, 1); PG8_STAGE(PG8_SB(1, 0), b3, voffB);
            PG8_BAR; PG8_WAIT_L(0); PG8_MMA(0, 1, At, B1); PG8_BAR;
            PG8_LDA(At, 1, 1); PG8_STAGE(PG8_SA(1, 0), a3, voffA);
            PG8_BAR; PG8_WAIT_L(0); PG8_MMA(1, 0, At, B0); PG8_BAR; PG8_SCHED;
            PG8_STAGE(PG8_SB(1, 1), b3 + hstep, voffB);
            PG8_WAIT_V(6); PG8_BAR; PG8_MMA(1, 1, At, B1); PG8_BAR;
        }
        PG8_STAMP();
        if constexpr (!Epi::AFTER_DRAIN) { E(acc, cur, wr, wc, fr, fq); S.done(cur); }
        PG8_STAMP();
        if (!has_next) break;
#pragma unroll
        for (int a = 0; a < 2; ++a)
#pragma unroll
            for (int b = 0; b < 2; ++b)
#pragma unroll
                for (int m = 0; m < 4; ++m)
#pragma unroll
                    for (int n = 0; n < 2; ++n) acc[a][b][m][n] = (f32x4){0.f, 0.f, 0.f, 0.f};
        cur = nxt; cA = nA; cB = nB; ++ui;
    }
    PG8_WAIT_V(0);
    if (wr == 0) PG8_BAR;
    PG8_BAR;
    if constexpr (Epi::AFTER_DRAIN) { E.fused(acc, cur, wr, wc, fr, fq, lds, wid, lane); S.done(cur); }
    PG8_STAMP();
    if (STAMP && wid == 0) { stamps[lane] = lane < nts ? (((unsigned long long)(unsigned)ts_hi << 32) | (unsigned)ts_lo) : 0ull;
        if (lane == 62) stamps[62] = rt_entry; if (lane == 63) stamps[63] = (unsigned long long)wall_clock64(); }
#undef PG8_STAMP
#undef PG8_SA
#undef PG8_SB
#undef PG8_STAGE
#undef PG8_LDA
#undef PG8_LDB
#undef PG8_MMA
#undef PG8_WAIT_V
#undef PG8_WAIT_L
#undef PG8_BAR
#undef PG8_SCHED
}
}

typedef unsigned short u16;
using pg8::bf16x8; using pg8::f32x4; using pg8::u32x4;
typedef short s16x4 __attribute__((ext_vector_type(4)));
typedef float f32x16 __attribute__((ext_vector_type(16)));
typedef float f32x2 __attribute__((ext_vector_type(2)));
typedef unsigned u32x2 __attribute__((ext_vector_type(2)));

constexpr int DM = 1024, SEQ = 16384, NMETA = 16, ST = 16400, TPAD = 16512, INW = 5632;
constexpr int FN1 = 164, FN2 = 100;
constexpr float EPS = 1e-6f;
constexpr size_t SZ_WIN = (size_t)INW * DM * 2, SZ_WFP = (size_t)1024 * 512 * 2, SZ_W1K = (size_t)1024 * 1024 * 2, SZ_MMIX = (size_t)512 * 1024 * 2;
constexpr size_t OFF_WIN = 0, OFF_WFP = OFF_WIN + 2 * SZ_WIN, OFF_WAP = OFF_WFP + 2 * SZ_WFP, OFF_WOUT = OFF_WAP + 2 * SZ_W1K, OFF_MMIX = OFF_WOUT + 2 * SZ_W1K;
constexpr size_t OFF_F1T = OFF_MMIX + 2 * SZ_MMIX, OFF_F2T = OFF_F1T + 512 * 256 * 2, OFF_TW = OFF_F2T + 256 * 256 * 2, OFF_CS = OFF_TW + 131328;
constexpr size_t OFF_HB = OFF_CS + 65536, SZ_T1K = (size_t)TPAD * 1024 * 2, OFF_SSQ = OFF_HB + SZ_T1K, OFF_HMETA = OFF_SSQ + (size_t)ST * 16 * 4;
constexpr size_t OFF_RSTD = OFF_HMETA + 65536, OFF_BAR = OFF_RSTD + 65792, OFF_MS = OFF_BAR + 16384, OFF_PM = OFF_MS + 163840, OFF_PL = OFF_PM + 65536, OFF_PO = OFF_PL + 65536, OFF_T = OFF_PO + (size_t)8 * 128 * 16 * 128 * 4;
constexpr size_t SZ_T512 = (size_t)TPAD * 512 * 2, OFF_K = OFF_T + SZ_T512, SZ_T256 = (size_t)TPAD * 256 * 2, OFF_V = OFF_K + SZ_T256, OFF_X = OFF_V + SZ_T256;
constexpr size_t OFF_Q = OFF_X, OFF_AG = OFF_Q + SZ_T1K, OFF_GT = OFF_AG + SZ_T1K, OFF_XEND = OFF_GT + 2 * SZ_T1K;
constexpr size_t SZ_UT = (size_t)512 * FN2 * 256 * 2, SZ_YT = (size_t)FN1 * 512 * 256 * 2;
constexpr size_t OFF_UT = OFF_X, OFF_YT = OFF_UT + SZ_UT, OFF_WB = OFF_YT + SZ_YT, OFF_FG = OFF_WB + SZ_T1K, OFF_XEND2 = OFF_FG + SZ_T512;
static_assert(OFF_XEND2 <= OFF_XEND, "FFT buffers must fit in the X region");
static_assert(OFF_XEND <= (size_t)256 * 1024 * 1024, "workspace over 256 MiB");
constexpr int LDS_BYTES = 131072 + 1024;

struct Params { const float *x, *meta, *norm_g, *w_in, *b_gate, *q_g, *k_g, *w_fmix, *w_fproj, *w_aproj, *w_out; float* out; unsigned char* ws; };

#ifndef PROBE_MASK
#define PROBE_MASK 0
#endif
__device__ __forceinline__ unsigned long long probe_t0() { return PROBE_MASK ? __builtin_amdgcn_s_memrealtime() : 0ull; }
__device__ __forceinline__ void probe_spin(int bit, unsigned long long t0) {
  if (PROBE_MASK & bit) { const unsigned long long t1 = __builtin_amdgcn_s_memrealtime(), te = t1 + (t1 - t0); while (__builtin_amdgcn_s_memrealtime() < te) __builtin_amdgcn_s_sleep(4); }
}
__device__ __forceinline__ int ltid() { int t = threadIdx.x; asm volatile("" : "+v"(t)); return t; }
typedef __bf16 bf16v2 __attribute__((ext_vector_type(2)));
__device__ __forceinline__ unsigned cvtpk(float lo, float hi) { const f32x2 v = {lo, hi}; const bf16v2 b = __builtin_convertvector(v, bf16v2); return __builtin_bit_cast(unsigned, b); }
__device__ __forceinline__ u16 f2bf(float x) { return (u16)(cvtpk(x, 0.f) & 0xffffu); }
__device__ __forceinline__ float bf2f(u16 b) { return __uint_as_float(((unsigned)b) << 16); }
__device__ __forceinline__ float bflo(unsigned w) { return __uint_as_float(w << 16); }
__device__ __forceinline__ float bfhi(unsigned w) { return __uint_as_float(w & 0xffff0000u); }
__device__ __forceinline__ u32x4 pack8(f32x4 a, f32x4 b) { u32x4 w; w.x = cvtpk(a[0], a[1]); w.y = cvtpk(a[2], a[3]); w.z = cvtpk(b[0], b[1]); w.w = cvtpk(b[2], b[3]); return w; }
__device__ __forceinline__ float silu_f(float x) { return x / (1.f + __expf(-x)); }
__device__ __forceinline__ float sigm_f(float x) { return 1.f / (1.f + __expf(-x)); }
__device__ __forceinline__ float wave_sum(float v) { for (int o = 32; o > 0; o >>= 1) v += __shfl_xor(v, o); return v; }
__device__ __forceinline__ float rstd_from_ssqp(const float* sp) {
  const f32x4 a = *(const f32x4*)sp, b = *(const f32x4*)(sp + 4), c = *(const f32x4*)(sp + 8), d = *(const f32x4*)(sp + 12);
  const float s = ((a[0] + a[1]) + (a[2] + a[3])) + ((b[0] + b[1]) + (b[2] + b[3])) + ((c[0] + c[1]) + (c[2] + c[3])) + ((d[0] + d[1]) + (d[2] + d[3]));
  return rsqrtf(s * (1.f / 1024.f) + EPS);
}
#define XB_TMO      128
#define XB_XCNT(j)  (256  + 64 * (j))
#define XB_XSUB(j)  (1280 + 64 * (j))
#define XB_XGEN(j)  (2304 + 64 * (j))
#define XB_TOP      3328
#define XB_TOPGEN   3392
#define XCD_BAR_WORDS 3456
#define XB_SPIN_CAP (1u << 18)
#define LAS __attribute__((address_space(3)))

__device__ __forceinline__ unsigned xb_ld(unsigned* p)              { return __hip_atomic_load(p, __ATOMIC_RELAXED, __HIP_MEMORY_SCOPE_AGENT); }
__device__ __forceinline__ unsigned xb_add(unsigned* p, unsigned v) { return __hip_atomic_fetch_add(p, v, __ATOMIC_RELAXED, __HIP_MEMORY_SCOPE_AGENT); }
__device__ __forceinline__ unsigned xb_xcc_id() { return (unsigned)__builtin_amdgcn_s_getreg((3 << 11) | 20) & 0xFu; }
#define XB_SPIN(cond, bar) do { unsigned _sp = 0; while (cond) { __builtin_amdgcn_s_sleep(1); \
    if ((++_sp & 255u) == 0u) { if (xb_ld(&(bar)[XB_TMO])) break; if (_sp > XB_SPIN_CAP) { atomicAdd(&(bar)[XB_TMO], 1u); break; } } } } while (0)

struct XcdBarrier {
    unsigned* bar; unsigned x;
    volatile LAS unsigned* st;
};

__device__ __forceinline__ XcdBarrier xcd_barrier_post(unsigned* bar, volatile LAS unsigned* st) {
    XcdBarrier b; b.bar = bar; b.x = xb_xcc_id(); b.st = st;
    if (threadIdx.x == 0) (void)xb_add(&bar[XB_XCNT(b.x)], 1u);
    return b;
}
__device__ __forceinline__ void xcd_barrier_complete(unsigned* bar, unsigned x, unsigned& nloc, unsigned& nx) {
    const unsigned G = gridDim.x * gridDim.y * gridDim.z;
    unsigned sum, cnt, mine, sp = 0u;
    for (;;) {
        sum = 0u; cnt = 0u; mine = 0u;
#pragma unroll
        for (unsigned j = 0; j < 16; ++j) { const unsigned c = xb_ld(&bar[XB_XCNT(j)]); sum += c; cnt += (c > 0u) ? 1u : 0u; mine = (j == x) ? c : mine; }
        if (sum == G) break;
        __builtin_amdgcn_s_sleep(1);
        if ((++sp & 255u) == 0u) { if (xb_ld(&bar[XB_TMO])) break; if (sp > XB_SPIN_CAP) { atomicAdd(&bar[XB_TMO], 1u); break; } }
    }
    nloc = mine > 0u ? mine : 1u; nx = cnt > 0u ? cnt : 1u;
}

__device__ __forceinline__ void xcd_barrier(const XcdBarrier& b) {
    asm volatile("s_waitcnt vmcnt(0)" ::: "memory");
    __syncthreads();
    if (threadIdx.x == 0) {
        unsigned* bar = b.bar;
        __builtin_amdgcn_s_waitcnt(0);
        unsigned nloc = b.st[0], nx = b.st[1];
        if (nloc == 0u) { xcd_barrier_complete(bar, b.x, nloc, nx); b.st[0] = nloc; b.st[1] = nx; }
        const unsigned old = xb_add(&bar[XB_XSUB(b.x)], 1u);
        const unsigned gen = old / nloc;
        if (old + 1u == (gen + 1u) * nloc) {
            __builtin_amdgcn_fence(__ATOMIC_RELEASE, "agent");
            asm volatile("s_waitcnt vmcnt(0)" ::: "memory");
            const unsigned og = xb_add(&bar[XB_TOP], 1u);
            const unsigned tg = og / nx;
            if (og + 1u == (tg + 1u) * nx) xb_add(&bar[XB_TOPGEN], 1u);
            else XB_SPIN(xb_ld(&bar[XB_TOPGEN]) == tg, bar);
            __builtin_amdgcn_fence(__ATOMIC_ACQUIRE, "agent");
            xb_add(&bar[XB_XGEN(b.x)], 1u);
            asm volatile("s_waitcnt vmcnt(0)" ::: "memory");
        } else {
            XB_SPIN(xb_ld(&bar[XB_XGEN(b.x)]) == gen, bar);
            __builtin_amdgcn_fence(__ATOMIC_ACQUIRE, "agent");
            asm volatile("s_waitcnt vmcnt(0)" ::: "memory");
        }
    }
    __syncthreads();
}

#define EPI_ROWS for (int ai = 0; ai < 2; ++ai) _Pragma("unroll") for (int m = 0; m < 4; ++m)
#define ROW_FENCE() do { asm volatile("" ::: "memory"); __builtin_amdgcn_sched_barrier(0); } while (0)
struct EpiA {
  static constexpr bool PERM = true, AFTER_DRAIN = false;
  u16 *fvn, *fg, *kb, *vb; int pn0;
  __device__ __forceinline__ void operator()(const f32x4 (&acc)[2][2][4][2], const pg8::Unit& u, int wr, int wc, int fr, int fq) const {
#pragma unroll
    EPI_ROWS {
      const int s = 16 + u.pm * 256 + ai * 128 + wr * 64 + m * 16 + fr;
#pragma unroll
      for (int bj = 0; bj < 2; ++bj) {
        const int pn = u.pn + pn0, col = pn * 256 + bj * 128 + wc * 32 + 8 * fq;
        u16* d = (pn < 2) ? fvn + (size_t)s * 512 + col : (pn < 4) ? fg + (size_t)s * 512 + (col - 512) : (pn == 4 ? kb + (size_t)s * 256 + (col - 1024) : vb + (size_t)s * 256 + (col - 1280));
        *(u32x4*)d = pack8(acc[ai][bj][m][0], acc[ai][bj][m][1]);
      }
    }
  }
};
struct EpiF1 {
  static constexpr bool PERM = false, AFTER_DRAIN = false;
  const float* tw; u16* yt;
  __device__ __forceinline__ void operator()(const f32x4 (&acc)[2][2][4][2], const pg8::Unit& u, int wr, int wc, int fr, int fq) const {
#pragma unroll
    for (int m = 0; m < 4; ++m) {
      const int k1 = u.pm * 128 + wr * 64 + m * 16 + fr;
      if (k1 < FN1) {
        f32x4 t0[2][2], t1[2][2]; int colx[2][2], s2[2][2];
#pragma unroll
        for (int bj = 0; bj < 2; ++bj)
#pragma unroll
          for (int n = 0; n < 2; ++n) { const int c0 = u.pn * 256 + bj * 128 + wc * 32 + n * 16 + 4 * fq; colx[bj][n] = c0 / FN2; s2[bj][n] = c0 - colx[bj][n] * FN2;
            const float* tp = tw + (size_t)(k1 * FN2 + s2[bj][n]) * 2; t0[bj][n] = *(const f32x4*)tp; t1[bj][n] = *(const f32x4*)(tp + 4); }
        __builtin_amdgcn_sched_barrier(0);
#pragma unroll
        for (int bj = 0; bj < 2; ++bj)
#pragma unroll
          for (int n = 0; n < 2; ++n) {
            const f32x4 re = acc[0][bj][m][n], im = acc[1][bj][m][n], a0 = t0[bj][n], a1 = t1[bj][n];
            const float yr0 = re[0] * a0[0] - im[0] * a0[1], yi0 = re[0] * a0[1] + im[0] * a0[0];
            const float yr1 = re[1] * a0[2] - im[1] * a0[3], yi1 = re[1] * a0[3] + im[1] * a0[2];
            const float yr2 = re[2] * a1[0] - im[2] * a1[1], yi2 = re[2] * a1[1] + im[2] * a1[0];
            const float yr3 = re[3] * a1[2] - im[3] * a1[3], yi3 = re[3] * a1[3] + im[3] * a1[2];
            u16* d = yt + ((size_t)k1 * 512 + colx[bj][n]) * 256 + s2[bj][n];
            u32x2 a; a.x = cvtpk(yr0, yr1); a.y = cvtpk(yr2, yr3); *(u32x2*)d = a;
            u32x2 b; b.x = cvtpk(yi0, yi1); b.y = cvtpk(yi2, yi3); *(u32x2*)(d + 128) = b;
          }
      }
    }
  }
};
struct EpiF2 {
  static constexpr bool PERM = true, AFTER_DRAIN = false;
  u16* wb;
  __device__ __forceinline__ void operator()(const f32x4 (&acc)[2][2][4][2], const pg8::Unit& u, int wr, int wc, int fr, int fq) const {
#pragma unroll
    EPI_ROWS {
      const int k2 = wr * 64 + m * 16 + fr;
      if (k2 < FN2) {
#pragma unroll
        for (int bj = 0; bj < 2; ++bj) {
          const int n = u.pn * 256 + bj * 128 + wc * 32 + 8 * fq, k1 = n >> 9, col = n & 511, g = col >> 7, c = col & 127;
          *(u32x4*)(wb + (size_t)(k1 + FN1 * k2) * 1024 + g * 256 + ai * 128 + c) = pack8(acc[ai][bj][m][0], acc[ai][bj][m][1]);
        }
      }
    }
  }
};
struct EpiMix {
  static constexpr bool PERM = true, AFTER_DRAIN = false;
  const u16* fg; const float* rstd; u16* t; int pn0;
  __device__ __forceinline__ void operator()(const f32x4 (&acc)[2][2][4][2], const pg8::Unit& u, int wr, int wc, int fr, int fq) const {
    const int col0 = (u.pn + pn0) * 256 + wc * 32 + 8 * fq;
#pragma unroll
    for (int ai = 0; ai < 2; ++ai) {
      const int s0 = 16 + u.pm * 256 + ai * 128 + wr * 64 + fr;
      u32x4 g[4][2]; float rs[4];
#pragma unroll
      for (int m = 0; m < 4; ++m) { rs[m] = rstd[s0 + m * 16];
#pragma unroll
        for (int bj = 0; bj < 2; ++bj) g[m][bj] = *(const u32x4*)(fg + (size_t)(s0 + m * 16) * 512 + col0 + bj * 128); }
      __builtin_amdgcn_sched_barrier(0);
#pragma unroll
      for (int m = 0; m < 4; ++m)
#pragma unroll
        for (int bj = 0; bj < 2; ++bj) { const u32x4 gg = g[m][bj]; const float r = rs[m]; f32x4 v0 = acc[ai][bj][m][0], v1 = acc[ai][bj][m][1];
          v0[0] *= silu_f(r * bflo(gg.x)); v0[1] *= silu_f(r * bfhi(gg.x)); v0[2] *= silu_f(r * bflo(gg.y)); v0[3] *= silu_f(r * bfhi(gg.y));
          v1[0] *= silu_f(r * bflo(gg.z)); v1[1] *= silu_f(r * bfhi(gg.z)); v1[2] *= silu_f(r * bflo(gg.w)); v1[3] *= silu_f(r * bfhi(gg.w));
          *(u32x4*)(t + (size_t)(s0 + m * 16) * 512 + col0 + bj * 128) = pack8(v0, v1); }
    }
  }
};
struct EpiE {
  static constexpr bool PERM = true, AFTER_DRAIN = false;
  const float* rstd; const float* bg; u16 *q, *ag, *gt;
  __device__ __forceinline__ void operator()(const f32x4 (&acc)[2][2][4][2], const pg8::Unit& u, int wr, int wc, int fr, int fq) const {
    float rsv[2][4];
#pragma unroll
    for (int ai = 0; ai < 2; ++ai)
#pragma unroll
      for (int m = 0; m < 4; ++m) rsv[ai][m] = rstd[16 + u.pm * 256 + ai * 128 + wr * 64 + m * 16 + fr];
#pragma unroll
    EPI_ROWS {
      const int s = 16 + u.pm * 256 + ai * 128 + wr * 64 + m * 16 + fr;
      const float rs = rsv[ai][m];
#pragma unroll
      for (int bj = 0; bj < 2; ++bj) {
        const int col = u.pn * 256 + bj * 128 + wc * 32 + 8 * fq;
        f32x4 v0 = acc[ai][bj][m][0] * rs, v1 = acc[ai][bj][m][1] * rs;
        if (u.pn < 4) *(u32x4*)(q + (size_t)s * 1024 + col) = pack8(v0, v1);
        else if (u.pn < 8) *(u32x4*)(ag + (size_t)s * 1024 + (col - 1024)) = pack8(v0, v1);
        else {
          const f32x4 b0 = *(const f32x4*)(bg + col - 2048), b1 = *(const f32x4*)(bg + col - 2048 + 4);
#pragma unroll
          for (int j = 0; j < 4; ++j) { v0[j] = sigm_f(v0[j] + b0[j]); v1[j] = sigm_f(v1[j] + b1[j]); }
          *(u32x4*)(gt + (size_t)s * 2048 + (col - 2048)) = pack8(v0, v1);
        }
      }
    }
  }
};
template <int SECOND> struct EpiG {
  static constexpr bool PERM = true, AFTER_DRAIN = false;
  const u16* gt; u16* mb;
  __device__ __forceinline__ void operator()(const f32x4 (&acc)[2][2][4][2], const pg8::Unit& u, int wr, int wc, int fr, int fq) const {
    const int col0 = u.pn * 256 + wc * 32 + 8 * fq;
#pragma unroll
    for (int ai = 0; ai < 2; ++ai) {
      const int s0 = 16 + u.pm * 256 + ai * 128 + wr * 64 + fr;
      u32x4 g[4][2], p[4][2];
#pragma unroll
      for (int m = 0; m < 4; ++m)
#pragma unroll
        for (int bj = 0; bj < 2; ++bj) { g[m][bj] = *(const u32x4*)(gt + (size_t)(s0 + m * 16) * 2048 + SECOND * 1024 + col0 + bj * 128);
          if (SECOND) p[m][bj] = *(const u32x4*)(mb + (size_t)(s0 + m * 16) * 1024 + col0 + bj * 128); }
      __builtin_amdgcn_sched_barrier(0);
#pragma unroll
      for (int m = 0; m < 4; ++m)
#pragma unroll
        for (int bj = 0; bj < 2; ++bj) { const u32x4 gg = g[m][bj]; f32x4 v0 = acc[ai][bj][m][0], v1 = acc[ai][bj][m][1];
          v0[0] *= bflo(gg.x); v0[1] *= bfhi(gg.x); v0[2] *= bflo(gg.y); v0[3] *= bfhi(gg.y); v1[0] *= bflo(gg.z); v1[1] *= bfhi(gg.z); v1[2] *= bflo(gg.w); v1[3] *= bfhi(gg.w);
          if (SECOND) { const u32x4 pp = p[m][bj]; v0[0] += bflo(pp.x); v0[1] += bfhi(pp.x); v0[2] += bflo(pp.y); v0[3] += bfhi(pp.y); v1[0] += bflo(pp.z); v1[1] += bfhi(pp.z); v1[2] += bflo(pp.w); v1[3] += bfhi(pp.w); }
          *(u32x4*)(mb + (size_t)(s0 + m * 16) * 1024 + col0 + bj * 128) = pack8(v0, v1); }
    }
  }
};
struct EpiH {
  static constexpr bool PERM = true, AFTER_DRAIN = false;
  const float* hin; float* hout; u16* hb; float* ssqp;
  __device__ __forceinline__ void operator()(const f32x4 (&acc)[2][2][4][2], const pg8::Unit& u, int wr, int wc, int fr, int fq) const {
    const int col0 = u.pn * 256 + wc * 32 + 8 * fq;
#pragma unroll
    for (int ai = 0; ai < 2; ++ai) {
      const int r0 = u.pm * 256 + ai * 128 + wr * 64 + fr;
      f32x4 h0[4][2], h1[4][2];
#pragma unroll
      for (int m = 0; m < 4; ++m)
#pragma unroll
        for (int bj = 0; bj < 2; ++bj) { const float* hp = hin + (size_t)(r0 + m * 16) * 1024 + col0 + bj * 128; h0[m][bj] = *(const f32x4*)hp; h1[m][bj] = *(const f32x4*)(hp + 4); }
      __builtin_amdgcn_sched_barrier(0);
#pragma unroll
      for (int m = 0; m < 4; ++m) { const int r = r0 + m * 16; float ss = 0.f;
#pragma unroll
        for (int bj = 0; bj < 2; ++bj) {
          const f32x4 v0 = acc[ai][bj][m][0] + h0[m][bj], v1 = acc[ai][bj][m][1] + h1[m][bj];
          float* op = hout + (size_t)r * 1024 + col0 + bj * 128; *(f32x4*)op = v0; *(f32x4*)(op + 4) = v1;
          *(u32x4*)(hb + (size_t)(16 + r) * 1024 + col0 + bj * 128) = pack8(v0, v1);
#pragma unroll
          for (int j = 0; j < 4; ++j) ss += v0[j] * v0[j] + v1[j] * v1[j];
        }
        ss += __shfl_xor(ss, 16); ss += __shfl_xor(ss, 32);
        if (fq == 0) ssqp[(size_t)(16 + r) * 16 + u.pn * 4 + wc] = ss; }
    }
  }
};
__device__ __forceinline__ void fix_rows4(u16* p  , const float* g, int s, bool valid, const float* cs, int lane) {
  const int c = lane & 15;
  u32x4 w = {0u, 0u, 0u, 0u}; if (valid) w = *(const u32x4*)(p + c * 8);
  float x[8] = {bflo(w.x), bfhi(w.x), bflo(w.y), bfhi(w.y), bflo(w.z), bfhi(w.z), bflo(w.w), bfhi(w.w)};
  float ss = 0.f;
#pragma unroll
  for (int i = 0; i < 8; ++i) ss += x[i] * x[i];
  ss += __shfl_xor(ss, 1); ss += __shfl_xor(ss, 2); ss += __shfl_xor(ss, 4); ss += __shfl_xor(ss, 8);
  const float rs = rsqrtf(ss * (1.f / 128.f) + EPS);
  const f32x4 g0 = *(const f32x4*)(g + c * 8), g1 = *(const f32x4*)(g + c * 8 + 4);
  float y[8], py[8];
#pragma unroll
  for (int i = 0; i < 4; ++i) { y[i] = x[i] * rs * g0[i]; y[4 + i] = x[4 + i] * rs * g1[i]; }
#pragma unroll
  for (int i = 0; i < 8; ++i) py[i] = __shfl_xor(y[i], 4);
  if (s >= 16) {
    const int t = s - 16, pos = (c < 8) ? (t >> 6) : (t & 63); const float* cp = cs + (size_t)(pos * 32 + (c & 3) * 8) * 2;
    const float sg = (c & 4) ? 1.f : -1.f;
#pragma unroll
    for (int i = 0; i < 4; ++i) { const f32x4 v = *(const f32x4*)(cp + i * 4);
      y[2 * i] = y[2 * i] * v[0] + sg * py[2 * i] * v[1]; y[2 * i + 1] = y[2 * i + 1] * v[2] + sg * py[2 * i + 1] * v[3]; }
  }
  if (valid) { u32x4 o; o.x = cvtpk(y[0], y[1]); o.y = cvtpk(y[2], y[3]); o.z = cvtpk(y[4], y[5]); o.w = cvtpk(y[6], y[7]); *(u32x4*)(p + c * 8) = o; }
}
template <int NH> __device__ __forceinline__ void fix_all(u16* buf, const float* g, const float* cs, int s_lo, int s_hi, int gw, int nw, int lane) {
  const int sub = lane >> 4, n = (s_hi - s_lo) * NH;
  for (int base = gw * 4; base < n; base += nw * 4) { const int idx = base + sub; const bool valid = idx < n; const int s = s_lo + idx / NH, hh = idx % NH;
    fix_rows4(buf + (size_t)s * (NH * 128) + hh * 128, g, s, valid, cs, lane); }
}

namespace att {
constexpr int D = 128, NW = 8, QBLK = 32, KVBLK = 64, LDQ = 1024, LDK = 256, LDO = 1024, KVALID = ST, NT = TPAD / KVBLK;
constexpr float SCALE = 0.088388347648318440f, THR = 8.f;
constexpr size_t SHM_V = KVBLK * D * 2, SHM_K = KVBLK * D * 2;
#define KSWZ(row, colB) ((row) * 256 + ((colB) ^ (((row) & 7) << 4)))
#define SBAR() __builtin_amdgcn_sched_barrier(0)
__device__ __forceinline__ int crow(int r, int hi) { return (r & 3) + 8 * (r >> 2) + 4 * hi; }
template <int MODE>
__device__ __forceinline__ void partialSM(f32x16& p0, f32x16& p1, float& m_reg, float& mn, float& alpha) {
  constexpr float C = SCALE * 1.4426950408889634f;
  if (MODE == 1) {
#pragma unroll
    for (int r = 8; r < 16; ++r) p0[r] = -1e30f;
  }
  if (MODE == 2) {
#pragma unroll
    for (int r = 0; r < 16; ++r) p0[r] = -1e30f;
  }
  if (MODE >= 1) {
#pragma unroll
    for (int r = 0; r < 16; ++r) p1[r] = -1e30f;
  }
  float pmax = p0[0];
#pragma unroll
  for (int r = 1; r < 16; ++r) pmax = fmaxf(pmax, p0[r]);
#pragma unroll
  for (int r = 0; r < 16; ++r) pmax = fmaxf(pmax, p1[r]);
  { auto rr = __builtin_amdgcn_permlane32_swap(__float_as_uint(pmax), __float_as_uint(pmax), false, false);
    pmax = fmaxf(__uint_as_float(rr[0]), __uint_as_float(rr[1])); }
  if (__builtin_expect(__all(pmax - m_reg <= THR / SCALE), 1)) { mn = m_reg; alpha = 1.f; }
  else { mn = fmaxf(m_reg, pmax); alpha = __builtin_amdgcn_exp2f((m_reg - mn) * C); m_reg = mn; }
  const float mnC = -mn * C;
#pragma unroll
  for (int r = 0; r < 16; ++r) p0[r] = fmaf(p0[r], C, mnC);
#pragma unroll
  for (int r = 0; r < 16; ++r) p1[r] = fmaf(p1[r], C, mnC);
#pragma unroll
  for (int r = 0; r < 16; ++r) p0[r] = __builtin_amdgcn_exp2f(p0[r]);
}
__device__ __forceinline__ void finishSM(f32x16& p0, f32x16& p1, float alpha, float& l_reg, bf16x8& pa0, bf16x8& pa1, bf16x8& pa2, bf16x8& pa3) {
#pragma unroll
  for (int r = 0; r < 16; ++r) p1[r] = __builtin_amdgcn_exp2f(p1[r]);
  float ps = 0;
#pragma unroll
  for (int r = 0; r < 16; ++r) ps += p0[r];
#pragma unroll
  for (int r = 0; r < 16; ++r) ps += p1[r];
  { auto rr = __builtin_amdgcn_permlane32_swap(__float_as_uint(ps), __float_as_uint(ps), false, false);
    ps = __uint_as_float(rr[0]) + __uint_as_float(rr[1]); }
  l_reg = l_reg * alpha + ps;
#define PK4(P, BASE, OUT) do { unsigned a0 = cvtpk(P[BASE + 0], P[BASE + 1]), a1 = cvtpk(P[BASE + 2], P[BASE + 3]);   \
    unsigned b0 = cvtpk(P[BASE + 4], P[BASE + 5]), b1 = cvtpk(P[BASE + 6], P[BASE + 7]);                              \
    auto r0 = __builtin_amdgcn_permlane32_swap(a0, b0, false, false); auto r1 = __builtin_amdgcn_permlane32_swap(a1, b1, false, false); \
    u32x4 w = {r0[0], r1[0], r0[1], r1[1]}; OUT = *reinterpret_cast<bf16x8*>(&w); } while (0)
  PK4(p0, 0, pa0); PK4(p0, 8, pa1); PK4(p1, 0, pa2); PK4(p1, 8, pa3);
#undef PK4
}
__device__ __forceinline__ void qkt(f32x16& p0, f32x16& p1, const char* Ks, const bf16x8* qr, int r32, int hi) {
  p0 = f32x16{}; p1 = f32x16{};
#pragma unroll
  for (int d0 = 0; d0 < 8; ++d0) { const int cb = (d0 * 16 + hi * 8) * 2;
    const bf16x8 b0 = *reinterpret_cast<const bf16x8*>(Ks + KSWZ(r32, cb));
    const bf16x8 b1 = *reinterpret_cast<const bf16x8*>(Ks + KSWZ(32 + r32, cb));
    p0 = __builtin_amdgcn_mfma_f32_32x32x16_bf16(b0, qr[d0], p0, 0, 0, 0);
    p1 = __builtin_amdgcn_mfma_f32_32x32x16_bf16(b1, qr[d0], p1, 0, 0, 0); }
}
__device__ __forceinline__ int v_st(int k, int c) { const int kk = (k & ~0xC) | ((k & 4) << 1) | ((k & 8) >> 1); return ((kk >> 3) * 4 + (c >> 5)) * 512 + ((kk & 7) * 32 + (c & 31)) * 2; }
__device__ __forceinline__ int v_rd_base(int lane) { return ((lane & 3) << 3) | (((lane >> 2) & 3) << 6) | (((lane >> 4) & 1) << 5) | (((lane >> 5) & 1) << 8); }
constexpr int v_rd_off(int d0, int ks, int half) { return d0 * 512 + ks * 4096 + half * 2048; }
template <int OFF> __device__ __forceinline__ s16x4 tr_read(int vb) {
  s16x4 r; asm volatile("ds_read_b64_tr_b16 %0, %1 offset:%2" : "=&v"(r) : "v"(vb), "i"(OFF) : "memory"); return r;
}
template <int D0> __device__ __forceinline__ void pv_one(f32x16& od, int vb, bf16x8 pa0, bf16x8 pa1, bf16x8 pa2, bf16x8 pa3) {
  const s16x4 l0 = tr_read<v_rd_off(D0, 0, 0)>(vb), h0 = tr_read<v_rd_off(D0, 0, 1)>(vb), l1 = tr_read<v_rd_off(D0, 1, 0)>(vb), h1 = tr_read<v_rd_off(D0, 1, 1)>(vb);
  const s16x4 l2 = tr_read<v_rd_off(D0, 2, 0)>(vb), h2 = tr_read<v_rd_off(D0, 2, 1)>(vb), l3 = tr_read<v_rd_off(D0, 3, 0)>(vb), h3 = tr_read<v_rd_off(D0, 3, 1)>(vb);
  asm volatile("s_waitcnt lgkmcnt(0)" ::: "memory"); SBAR();
#define PK(L, H) (bf16x8){L[0], L[1], L[2], L[3], H[0], H[1], H[2], H[3]}
  od = __builtin_amdgcn_mfma_f32_32x32x16_bf16(pa0, PK(l0, h0), od, 0, 0, 0);
  od = __builtin_amdgcn_mfma_f32_32x32x16_bf16(pa1, PK(l1, h1), od, 0, 0, 0);
  od = __builtin_amdgcn_mfma_f32_32x32x16_bf16(pa2, PK(l2, h2), od, 0, 0, 0);
  od = __builtin_amdgcn_mfma_f32_32x32x16_bf16(pa3, PK(l3, h3), od, 0, 0, 0);
#undef PK
}
__device__ __forceinline__ void pv_d0(f32x16* o, int vb, bf16x8 pa0, bf16x8 pa1, bf16x8 pa2, bf16x8 pa3) {
  pv_one<0>(o[0], vb, pa0, pa1, pa2, pa3); pv_one<1>(o[1], vb, pa0, pa1, pa2, pa3); pv_one<2>(o[2], vb, pa0, pa1, pa2, pa3); pv_one<3>(o[3], vb, pa0, pa1, pa2, pa3);
}
template <int MODE>
__device__ __forceinline__ void pv_sm(f32x16* o, int vb, bf16x8 pa0, bf16x8 pa1, bf16x8 pa2, bf16x8 pa3, f32x16& p0, f32x16& p1, float& m_reg, float& mn, float& alpha) {
  constexpr float C = SCALE * 1.4426950408889634f;
  pv_one<0>(o[0], vb, pa0, pa1, pa2, pa3);
  if (MODE == 1) {
#pragma unroll
    for (int r = 8; r < 16; ++r) p0[r] = -1e30f;
  }
  if (MODE == 2) {
#pragma unroll
    for (int r = 0; r < 16; ++r) p0[r] = -1e30f;
  }
  if (MODE >= 1) {
#pragma unroll
    for (int r = 0; r < 16; ++r) p1[r] = -1e30f;
  }
  float pmax = p0[0];
#pragma unroll
  for (int r = 1; r < 16; ++r) pmax = fmaxf(pmax, p0[r]);
  pv_one<1>(o[1], vb, pa0, pa1, pa2, pa3);
#pragma unroll
  for (int r = 0; r < 16; ++r) pmax = fmaxf(pmax, p1[r]);
  { auto rr = __builtin_amdgcn_permlane32_swap(__float_as_uint(pmax), __float_as_uint(pmax), false, false);
    pmax = fmaxf(__uint_as_float(rr[0]), __uint_as_float(rr[1])); }
  if (__builtin_expect(__all(pmax - m_reg <= THR / SCALE), 1)) { mn = m_reg; alpha = 1.f; }
  else { mn = fmaxf(m_reg, pmax); alpha = __builtin_amdgcn_exp2f((m_reg - mn) * C); m_reg = mn; }
  const float mnC = -mn * C;
  pv_one<2>(o[2], vb, pa0, pa1, pa2, pa3);
#pragma unroll
  for (int r = 0; r < 16; ++r) p0[r] = fmaf(p0[r], C, mnC);
#pragma unroll
  for (int r = 0; r < 16; ++r) p1[r] = fmaf(p1[r], C, mnC);
  pv_one<3>(o[3], vb, pa0, pa1, pa2, pa3);
#pragma unroll
  for (int r = 0; r < 16; ++r) p0[r] = __builtin_amdgcn_exp2f(p0[r]);
}

__device__ __forceinline__ void attn_body(const u16* __restrict__ Qb, const u16* __restrict__ Kh, const u16* __restrict__ Vh, u16* Ob, const u16* __restrict__ Gb, char* lds) {
  const int tid = ltid(), wid = tid >> 6, lane = tid & 63, r32 = lane & 31, hi = lane >> 5;
  char* V_lds = lds; char* K_lds = lds + 2 * SHM_V;
  float* ws = (float*)(lds + 2 * SHM_V + 2 * SHM_K) + wid * 64; float* li_l = ws; float* al_l = ws + 32;
  float m_reg = -1e30f, l_reg = 0; f32x16 o[4] = {}; bf16x8 qr[8];
  const u16* Qw = Qb + (long)(wid * QBLK + r32) * LDQ + hi * 8;
#pragma unroll
  for (int d0 = 0; d0 < 8; ++d0) qr[d0] = *reinterpret_cast<const bf16x8*>(Qw + d0 * 16);
  const int sr = tid >> 4, sc = (tid & 15) * 8, vst0 = v_st(sr, sc), vst1 = v_st(32 + sr, sc);
  const int vb0 = (int)(uintptr_t)V_lds + v_rd_base(lane);
  bf16x8 e_vs0, e_vs1, e_ks0, e_ks1, o_vs0, o_vs1, o_ks0, o_ks1;
#define SLOAD_E(k0) do { e_vs0 = *(const bf16x8*)&Vh[(long)((k0) + sr) * LDK + sc]; e_vs1 = *(const bf16x8*)&Vh[(long)((k0) + 32 + sr) * LDK + sc]; \
    e_ks0 = *(const bf16x8*)&Kh[(long)((k0) + sr) * LDK + sc]; e_ks1 = *(const bf16x8*)&Kh[(long)((k0) + 32 + sr) * LDK + sc]; } while (0)
#define SLOAD_O(k0) do { o_vs0 = *(const bf16x8*)&Vh[(long)((k0) + sr) * LDK + sc]; o_vs1 = *(const bf16x8*)&Vh[(long)((k0) + 32 + sr) * LDK + sc]; \
    o_ks0 = *(const bf16x8*)&Kh[(long)((k0) + sr) * LDK + sc]; o_ks1 = *(const bf16x8*)&Kh[(long)((k0) + 32 + sr) * LDK + sc]; } while (0)
#define SWRITE(b, P) do { *(bf16x8*)(V_lds + (b) * SHM_V + vst0) = P##_vs0; *(bf16x8*)(V_lds + (b) * SHM_V + vst1) = P##_vs1; const int kc = sc * 2; \
    *(bf16x8*)(K_lds + (b) * SHM_K + KSWZ(sr, kc)) = P##_ks0; *(bf16x8*)(K_lds + (b) * SHM_K + KSWZ(32 + sr, kc)) = P##_ks1; } while (0)
#define SWAIT() asm volatile("s_waitcnt vmcnt(4)" ::: "memory")
#define RESC(a) do { if (__any((a) < 1.f)) { if (hi == 0) al_l[r32] = (a); asm volatile("s_waitcnt lgkmcnt(0)" ::: "memory"); \
    _Pragma("unroll") for (int d = 0; d < 4; ++d) _Pragma("unroll") for (int r = 0; r < 16; ++r) o[d][r] *= al_l[crow(r, hi)]; } } while (0)
  f32x16 pA0, pA1, pB0, pB1; float mnA, mnB, alA, alB; bf16x8 pa0, pa1, pa2, pa3;
#define ITER(J, MB, MA, LOADE) do { \
    SBAR(); qkt(pB0, pB1, K_lds + SHM_K, qr, r32, hi); \
    finishSM(pA0, pA1, alA, l_reg, pa0, pa1, pa2, pa3); SBAR(); \
    SLOAD_O(((J) + 2) * KVBLK); SBAR(); \
    pv_sm<MB>(o, vb0, pa0, pa1, pa2, pa3, pB0, pB1, m_reg, mnB, alB); \
    __syncthreads(); SWAIT(); SWRITE(0, e); \
    RESC(alB); __syncthreads(); \
    SBAR(); qkt(pA0, pA1, K_lds, qr, r32, hi); \
    finishSM(pB0, pB1, alB, l_reg, pa0, pa1, pa2, pa3); SBAR(); \
    if (LOADE) SLOAD_E(((J) + 3) * KVBLK); SBAR(); \
    pv_sm<MA>(o, vb0 + (int)SHM_V, pa0, pa1, pa2, pa3, pA0, pA1, m_reg, mnA, alA); \
    __syncthreads(); SWAIT(); SWRITE(1, o); \
    RESC(alA); __syncthreads(); } while (0)
  SLOAD_E(0); asm volatile("s_waitcnt vmcnt(0)" ::: "memory"); SWRITE(0, e); __syncthreads();
  qkt(pA0, pA1, K_lds, qr, r32, hi); partialSM<0>(pA0, pA1, m_reg, mnA, alA);
  SLOAD_O(KVBLK); SLOAD_E(2 * KVBLK);
  SWAIT(); SWRITE(1, o); __syncthreads();
#pragma unroll 1
  for (int j = 1; j < NT - 3; j += 2) ITER(j, 0, 0, 1);
  ITER(NT - 3, 0, 1, 0);
  SBAR(); qkt(pB0, pB1, K_lds + SHM_K, qr, r32, hi);
  finishSM(pA0, pA1, alA, l_reg, pa0, pa1, pa2, pa3); SBAR();
  pv_sm<2>(o, vb0, pa0, pa1, pa2, pa3, pB0, pB1, m_reg, mnB, alB);
  __syncthreads(); RESC(alB);
  finishSM(pB0, pB1, alB, l_reg, pa0, pa1, pa2, pa3); SBAR();
  pv_d0(o, vb0 + (int)SHM_V, pa0, pa1, pa2, pa3);
  __syncthreads();
  if (hi == 0) li_l[r32] = l_reg; asm volatile("s_waitcnt lgkmcnt(0)" ::: "memory");
  { char* Ow = lds + wid * 8192;
#pragma unroll
    for (int r = 0; r < 16; ++r) { const int orow = crow(r, hi); const float rl = __builtin_amdgcn_rcpf(li_l[orow]);
#pragma unroll
      for (int d0 = 0; d0 < 4; ++d0) *(u16*)(Ow + orow * 256 + (d0 * 32 + r32) * 2) = f2bf(o[d0][r] * rl); }
    asm volatile("s_waitcnt lgkmcnt(0)" ::: "memory");
#pragma unroll
    for (int i = 0; i < 8; ++i) { const int id = i * 64 + lane, row = id >> 4, ch = id & 15;
      const u32x4 ov = *(const u32x4*)(Ow + row * 256 + ch * 16); const long gi = (long)(wid * QBLK + row) * LDO + ch * 8; const u32x4 g = *(const u32x4*)(Gb + gi);
      u32x4 w; w.x = cvtpk(bflo(ov.x) * silu_f(bflo(g.x)), bfhi(ov.x) * silu_f(bfhi(g.x))); w.y = cvtpk(bflo(ov.y) * silu_f(bflo(g.y)), bfhi(ov.y) * silu_f(bfhi(g.y)));
      w.z = cvtpk(bflo(ov.z) * silu_f(bflo(g.z)), bfhi(ov.z) * silu_f(bfhi(g.z))); w.w = cvtpk(bflo(ov.w) * silu_f(bflo(g.w)), bfhi(ov.w) * silu_f(bfhi(g.w)));
      *(u32x4*)(Ob + gi) = w; } }
  __syncthreads();
#undef ITER
#undef SLOAD_E
#undef SLOAD_O
#undef SWRITE
#undef SWAIT
#undef RESC
}
}
__device__ __forceinline__ float block_reduce(float v, float* red, bool is_max) {
  const int tl = ltid(), lane = tl & 63, wid = tl >> 6;
  for (int o = 32; o > 0; o >>= 1) { const float t = __shfl_xor(v, o); v = is_max ? fmaxf(v, t) : v + t; }
  __syncthreads();
  if (lane == 0) red[wid] = v;
  __syncthreads();
  float r = red[0];
  for (int i = 1; i < 8; ++i) r = is_max ? fmaxf(r, red[i]) : r + red[i];
  return r;
}
__device__ void meta_attn_partial(int j, const u16* msq, const u16* kb, const u16* vb, float* PM, float* PL, float* PO) {
  const int tid = ltid(), lane = tid & 63, wid = tid >> 6, g = lane >> 4, li = lane & 15;
  const int kvh = j & 1, c = j >> 1, half = wid >> 2, h = kvh * 4 + (wid & 3), step0 = c * 8 + half * 4, nsteps = 4 + ((c == 63 && half == 1) ? 1 : 0);
  bf16x8 qf[4];
#pragma unroll
  for (int ks = 0; ks < 4; ++ks) qf[ks] = *(const bf16x8*)(msq + (size_t)li * 1024 + h * 128 + ks * 32 + g * 8);
  f32x4 o[8];
#pragma unroll
  for (int db = 0; db < 8; ++db) o[db] = (f32x4){0.f, 0.f, 0.f, 0.f};
  float m_run = -1e30f, l_run = 0.f;
  for (int st = 0; st < nsteps; ++st) {
    const int key0 = (step0 + st) * 32;
    f32x4 s0 = {0.f, 0.f, 0.f, 0.f}, s1 = {0.f, 0.f, 0.f, 0.f};
    const u16* kp = kb + (size_t)(key0 + li) * 256 + kvh * 128 + g * 8;
    bf16x8 k0[4], k1[4];
#pragma unroll
    for (int ks = 0; ks < 4; ++ks) { k0[ks] = *(const bf16x8*)(kp + ks * 32); k1[ks] = *(const bf16x8*)(kp + 16 * 256 + ks * 32); }
    const u16* vp = vb + (size_t)(key0 + 4 * g) * 256 + kvh * 128 + li;
    u32x4 vw[8];
#pragma unroll
    for (int db = 0; db < 8; ++db) { const u16* q = vp + db * 16;
      vw[db].x = (unsigned)q[0] | ((unsigned)q[256] << 16); vw[db].y = (unsigned)q[512] | ((unsigned)q[768] << 16);
      vw[db].z = (unsigned)q[16 * 256] | ((unsigned)q[17 * 256] << 16); vw[db].w = (unsigned)q[18 * 256] | ((unsigned)q[19 * 256] << 16); }
#pragma unroll
    for (int ks = 0; ks < 4; ++ks) { s0 = __builtin_amdgcn_mfma_f32_16x16x32_bf16(k0[ks], qf[ks], s0, 0, 0, 0); s1 = __builtin_amdgcn_mfma_f32_16x16x32_bf16(k1[ks], qf[ks], s1, 0, 0, 0); }
    float mx = -1e30f;
#pragma unroll
    for (int r = 0; r < 4; ++r) { float a = s0[r] * att::SCALE; if (key0 + 4 * g + r >= ST) a = -1e30f; s0[r] = a; mx = fmaxf(mx, a);
      float b = s1[r] * att::SCALE; if (key0 + 16 + 4 * g + r >= ST) b = -1e30f; s1[r] = b; mx = fmaxf(mx, b); }
    mx = fmaxf(mx, __shfl_xor(mx, 16)); mx = fmaxf(mx, __shfl_xor(mx, 32));
    const float mn = fmaxf(m_run, mx), alpha = __expf(m_run - mn); m_run = mn;
    float ps = 0.f;
#pragma unroll
    for (int r = 0; r < 4; ++r) { s0[r] = __expf(s0[r] - mn); s1[r] = __expf(s1[r] - mn); ps += s0[r] + s1[r]; }
    ps += __shfl_xor(ps, 16); ps += __shfl_xor(ps, 32);
    l_run = l_run * alpha + ps;
    float ar[4];
#pragma unroll
    for (int r = 0; r < 4; ++r) ar[r] = __shfl(alpha, 4 * g + r);
    u32x4 pw; pw.x = cvtpk(s0[0], s0[1]); pw.y = cvtpk(s0[2], s0[3]); pw.z = cvtpk(s1[0], s1[1]); pw.w = cvtpk(s1[2], s1[3]);
    const bf16x8 pf = *reinterpret_cast<const bf16x8*>(&pw);
#pragma unroll
    for (int db = 0; db < 8; ++db) {
#pragma unroll
      for (int r = 0; r < 4; ++r) o[db][r] *= ar[r];
      o[db] = __builtin_amdgcn_mfma_f32_16x16x32_bf16(pf, *reinterpret_cast<const bf16x8*>(&vw[db]), o[db], 0, 0, 0); }
  }
  const size_t base = (size_t)h * 128 + c * 2 + half;
  if (g == 0) { PM[base * 16 + li] = m_run; PL[base * 16 + li] = l_run; }
#pragma unroll
  for (int db = 0; db < 8; ++db)
#pragma unroll
    for (int r = 0; r < 4; ++r) PO[(base * 16 + 4 * g + r) * 128 + db * 16 + li] = o[db][r];
}
__device__ void meta_attn_combine(int b, const float* PM, const float* PL, const float* PO, const u16* msag, u16* msog, char* lds) {
  const int tid = ltid(), h = b >> 4, r = b & 15;
  float* red = (float*)lds; float* wts = red + 16; float* part = wts + 128;
  const float m_s = tid < 128 ? PM[((size_t)h * 128 + tid) * 16 + r] : -1e30f;
  const float M = block_reduce(m_s, red, true);
  float lw = 0.f; if (tid < 128) { const float w = __expf(m_s - M); wts[tid] = w; lw = PL[((size_t)h * 128 + tid) * 16 + r] * w; }
  const float L = block_reduce(lw, red, false);
  const int d = tid & 127, pt = tid >> 7; float acc = 0.f;
#pragma unroll 8
  for (int s = pt * 32; s < pt * 32 + 32; ++s) acc += PO[(((size_t)h * 128 + s) * 16 + r) * 128 + d] * wts[s];
  part[pt * 128 + d] = acc;
  __syncthreads();
  if (tid < 128) { const float o = (part[tid] + part[128 + tid]) + (part[256 + tid] + part[384 + tid]); const float gv = bf2f(msag[(size_t)r * 1024 + h * 128 + tid]);
    msog[(size_t)r * 1024 + h * 128 + tid] = f2bf(o / L * silu_f(gv)); }
  __syncthreads();
}

template <int K, class F> __device__ __forceinline__ void meta_gemm_wg(const u16* A, const u16* Bt, int N, int t0, int tstride, float* sc, F epi) {
  const int tid = ltid(), lane = tid & 63, wid = tid >> 6; constexpr int KS = K / 8, NST = KS / 32;
  for (int tile = t0; tile < N / 16; tile += tstride) {
    f32x4 acc = {0.f, 0.f, 0.f, 0.f};
    const u16* ap = A + (size_t)(lane & 15) * K + wid * KS + 8 * (lane >> 4); const u16* bp = Bt + (size_t)(tile * 16 + (lane & 15)) * K + wid * KS + 8 * (lane >> 4);
    bf16x8 av[NST], bv[NST];
#pragma unroll
    for (int i = 0; i < NST; ++i) { av[i] = *(const bf16x8*)(ap + i * 32); bv[i] = *(const bf16x8*)(bp + i * 32); }
#pragma unroll
    for (int i = 0; i < NST; ++i) acc = __builtin_amdgcn_mfma_f32_16x16x32_bf16(av[i], bv[i], acc, 0, 0, 0);
    *(f32x4*)(sc + (wid * 64 + lane) * 4) = acc;
    __syncthreads();
    if (wid == 0) { f32x4 s = *(const f32x4*)(sc + lane * 4);
#pragma unroll
      for (int w = 1; w < 8; ++w) s += *(const f32x4*)(sc + (w * 64 + lane) * 4);
      epi(tile * 16 + (lane & 15), (lane >> 4) * 4, s); }
    __syncthreads();
  }
}
template <class F> __device__ __forceinline__ void meta_gemm_mix(const u16* A, const u16* Bt, int t0, int tstride, float* sc, F epi) {
  const int tid = ltid(), lane = tid & 63, wid = tid >> 6;
  for (int tile = t0; tile < 32; tile += tstride) {
    f32x4 acc = {0.f, 0.f, 0.f, 0.f};
    const u16* ap = A + (size_t)(lane & 15) * 1024 + (tile >> 4) * 512 + wid * 64 + 8 * (lane >> 4); const u16* bp = Bt + (size_t)(tile * 16 + (lane & 15)) * 512 + wid * 64 + 8 * (lane >> 4);
    const bf16x8 a0 = *(const bf16x8*)ap, a1 = *(const bf16x8*)(ap + 32), b0 = *(const bf16x8*)bp, b1 = *(const bf16x8*)(bp + 32);
    acc = __builtin_amdgcn_mfma_f32_16x16x32_bf16(a0, b0, acc, 0, 0, 0); acc = __builtin_amdgcn_mfma_f32_16x16x32_bf16(a1, b1, acc, 0, 0, 0);
    *(f32x4*)(sc + (wid * 64 + lane) * 4) = acc;
    __syncthreads();
    if (wid == 0) { f32x4 s = *(const f32x4*)(sc + lane * 4);
#pragma unroll
      for (int w = 1; w < 8; ++w) s += *(const f32x4*)(sc + (w * 64 + lane) * 4);
      epi(tile * 16 + (lane & 15), (lane >> 4) * 4, s); }
    __syncthreads();
  }
}
__device__ __forceinline__ void meta_rstd_wg(const float* hmeta, float* sc2, float* rsl) {
  const int tid = ltid(), lane = tid & 63, wid = tid >> 6; const f32x4* hp = (const f32x4*)(hmeta + (size_t)(lane & 15) * 1024 + wid * 128 + (lane >> 4) * 32); float ss = 0.f;
#pragma unroll
  for (int i = 0; i < 8; ++i) { const f32x4 v = hp[i]; ss += v[0] * v[0] + v[1] * v[1] + v[2] * v[2] + v[3] * v[3]; }
  ss += __shfl_xor(ss, 16); ss += __shfl_xor(ss, 32);
  if (lane < 16) sc2[wid * 16 + lane] = ss;
  __syncthreads();
  if (tid < 16) { float t = 0.f;
#pragma unroll
    for (int w = 0; w < 8; ++w) t += sc2[w * 16 + tid];
    rsl[tid] = rsqrtf(t * (1.f / 1024.f) + EPS); }
  __syncthreads();
}

__device__ void fval_transpose(const u16* fvn, const float* rstd, u16* ut, char* lds) {
  const int tid = ltid(); u16* tile = (u16*)lds;
  for (int job = blockIdx.x; job < 800; job += gridDim.x) {
    const int s2 = job % FN2, cb = job / FN2;
    u32x4 wv[3]; float rv[3];
#pragma unroll
    for (int i = 0; i < 3; ++i) { const int idx = tid + i * 512; if (idx < FN1 * 8) { const int s = FN2 * (idx >> 3) + s2; wv[i] = *(const u32x4*)(fvn + (size_t)s * 512 + cb * 64 + (idx & 7) * 8); rv[i] = rstd[s]; } }
#pragma unroll
    for (int i = 0; i < 3; ++i) { const int idx = tid + i * 512; if (idx < FN1 * 8) { const int s1 = idx >> 3, ch = idx & 7; const u32x4 w = wv[i]; const float rs = rv[i]; u16* tp = tile + (ch * 8) * 168 + s1;
      tp[0 * 168] = f2bf(rs * bflo(w.x)); tp[1 * 168] = f2bf(rs * bfhi(w.x)); tp[2 * 168] = f2bf(rs * bflo(w.y)); tp[3 * 168] = f2bf(rs * bfhi(w.y));
      tp[4 * 168] = f2bf(rs * bflo(w.z)); tp[5 * 168] = f2bf(rs * bfhi(w.z)); tp[6 * 168] = f2bf(rs * bflo(w.w)); tp[7 * 168] = f2bf(rs * bfhi(w.w)); } }
    if (tid < 256) tile[(tid >> 2) * 168 + FN1 + (tid & 3)] = 0;
    __syncthreads();
    for (int idx = tid; idx < 64 * 21; idx += 512) { const int c = idx / 21, k = idx - c * 21;
      *(u32x4*)(ut + ((size_t)(cb * 64 + c) * FN2 + s2) * 256 + k * 8) = *(const u32x4*)(tile + c * 168 + k * 8); }
    __syncthreads();
  }
}
__device__ __forceinline__ int win_src_col(int np) {
  return np < 1024 ? np : (np < 1536 ? np + 1024 : (np < 2560 ? np - 512 : np));
}
__device__ __forceinline__ void transpose_tile(const float* src, int lds_, u16* dst, int ldd, const float* scale, u16* tile, int tl) {
  { const int r = tl >> 3, ch = tl & 7; const float* sp = src + (size_t)r * lds_ + ch * 8; const f32x4 a = *(const f32x4*)sp, b = *(const f32x4*)(sp + 4); const float sc = scale ? scale[r] : 1.f;
#pragma unroll
    for (int i = 0; i < 4; ++i) { tile[(ch * 8 + i) * 66 + r] = f2bf(a[i] * sc); tile[(ch * 8 + 4 + i) * 66 + r] = f2bf(b[i] * sc); } }
  __syncthreads();
  { const int n = tl >> 3, kc = tl & 7; const u16* tp = tile + n * 66 + kc * 8; u32x4 w;
    w.x = (unsigned)tp[0] | ((unsigned)tp[1] << 16); w.y = (unsigned)tp[2] | ((unsigned)tp[3] << 16); w.z = (unsigned)tp[4] | ((unsigned)tp[5] << 16); w.w = (unsigned)tp[6] | ((unsigned)tp[7] << 16);
    *(u32x4*)(dst + (size_t)n * ldd + kc * 8) = w; }
  __syncthreads();
}
__device__ __forceinline__ int transpose_all(const float* src, u16* dst, int K, int N, const float* scale, bool remap, u16* tile, int tl, int t0) {
  const int nkb = K >> 6, nnb = N >> 6, nt = nkb * nnb, G = (int)gridDim.x, r = tl >> 3, ch = tl & 7;
  int t = (int)blockIdx.x - (t0 % G); if (t < 0) t += G;
  f32x4 a = {0.f, 0.f, 0.f, 0.f}, b = a; float sc = 1.f;
  if (t < nt) { const int nb = t % nnb, kb = t / nnb, n0 = remap ? win_src_col(nb * 64) : nb * 64; const float* sp = src + ((size_t)kb * 64 + r) * N + n0 + ch * 8;
    a = *(const f32x4*)sp; b = *(const f32x4*)(sp + 4); sc = scale ? scale[kb * 64 + r] : 1.f; }
  for (; t < nt; t += G) {
#pragma unroll
    for (int i = 0; i < 4; ++i) { tile[(ch * 8 + i) * 66 + r] = f2bf(a[i] * sc); tile[(ch * 8 + 4 + i) * 66 + r] = f2bf(b[i] * sc); }
    __syncthreads();
    const int tn = t + G;
    if (tn < nt) { const int nb = tn % nnb, kb = tn / nnb, n0 = remap ? win_src_col(nb * 64) : nb * 64; const float* sp = src + ((size_t)kb * 64 + r) * N + n0 + ch * 8;
      a = *(const f32x4*)sp; b = *(const f32x4*)(sp + 4); sc = scale ? scale[kb * 64 + r] : 1.f; }
    { const int nb = t % nnb, kb = t / nnb; const int n = tl >> 3, kc = tl & 7; const u16* tp = tile + n * 66 + kc * 8; u32x4 w;
      w.x = (unsigned)tp[0] | ((unsigned)tp[1] << 16); w.y = (unsigned)tp[2] | ((unsigned)tp[3] << 16); w.z = (unsigned)tp[4] | ((unsigned)tp[5] << 16); w.w = (unsigned)tp[6] | ((unsigned)tp[7] << 16);
      *(u32x4*)(dst + ((size_t)nb * 64 + n) * K + kb * 64 + kc * 8) = w; }
    __syncthreads();
  }
  return t0 + nt;
}
__device__ void prep_phase(const Params& p, char* lds) {
  const int tl = ltid(); const size_t gt = (size_t)blockIdx.x * 512 + tl, gs = (size_t)gridDim.x * 512;
  unsigned char* ws = p.ws;
  float* tab = (float*)lds;
  if (tl < 128) { float s, c; sincospif((float)tl / 64.f, &s, &c); tab[tl] = c; tab[128 + tl] = s; }
  __syncthreads();
  int tcur = 0;
  for (int l = 0; l < 2; ++l) {
    u16* tile = (u16*)(lds + 1024);
    tcur = transpose_all(p.w_in + (size_t)l * DM * INW, (u16*)(ws + OFF_WIN + l * SZ_WIN), 1024, INW, p.norm_g + l * DM, true, tile, tl, tcur);
    tcur = transpose_all(p.w_fproj + (size_t)l * 512 * 1024, (u16*)(ws + OFF_WFP + l * SZ_WFP), 512, 1024, nullptr, false, tile, tl, tcur);
    tcur = transpose_all(p.w_aproj + (size_t)l * 1024 * 1024, (u16*)(ws + OFF_WAP + l * SZ_W1K), 1024, 1024, nullptr, false, tile, tl, tcur);
    tcur = transpose_all(p.w_out + (size_t)l * 1024 * 1024, (u16*)(ws + OFF_WOUT + l * SZ_W1K), 1024, 1024, nullptr, false, tile, tl, tcur);
    { u16* dst = (u16*)(ws + OFF_MMIX + l * SZ_MMIX); const float* wm = p.w_fmix + (size_t)l * 4 * 128 * 128;
      for (size_t it = gt; it < (size_t)4 * 2 * 128 * 128; it += gs) {
        const int d = (int)(it & 127), c = (int)((it >> 7) & 127), ri = (int)((it >> 14) & 1), g = (int)(it >> 15);
        const float* wp = wm + (size_t)g * 16384 + d; const float* tb = tab + ri * 128; float a = 0.f;
        for (int cp = 0; cp < 128; ++cp) a += tb[(c * cp) & 127] * wp[(size_t)cp * 128];
        dst[(size_t)(g * 128 + d) * 512 + (g & 1) * 256 + ri * 128 + c] = f2bf(a * 0.08838834764831845f);
      }
      for (size_t it = gt; it < (size_t)512 * 64; it += gs) {
        const int n = (int)(it >> 6), kc = (int)(it & 63);
        if ((kc >> 5) != ((n >> 7) & 1)) { u32x4 z = {0u, 0u, 0u, 0u}; *(u32x4*)(dst + (size_t)n * 512 + kc * 8) = z; }
      } }
  }
  { u16* dst = (u16*)(ws + OFF_F1T);
    for (size_t it = gt; it < (size_t)512 * 256; it += gs) {
      const int col = (int)(it & 255), row = (int)(it >> 8), k1 = (row >> 8) * 128 + (row & 127), ri = (row >> 7) & 1; float v = 0.f;
      if (k1 < FN1 && col < FN1) { float s, c; sincospif((float)(2 * ((k1 * col) % FN1)) / (float)FN1, &s, &c); v = (ri ? -s : c) * 0.07808688094430304f; }
      dst[it] = f2bf(v);
    } }
  { u16* dst = (u16*)(ws + OFF_F2T);
    for (size_t it = gt; it < (size_t)256 * 256; it += gs) {
      const int col = (int)(it & 255), row = (int)(it >> 8), k2 = row & 127, s2 = col & 127, ro = row >> 7, ri = col >> 7; float v = 0.f;
      if (k2 < FN2 && s2 < FN2) { float s, c; sincospif((float)(2 * ((k2 * s2) % FN2)) / (float)FN2, &s, &c); v = (ro == ri ? c : (ro == 0 ? s : -s)) * 0.1f; }
      dst[it] = f2bf(v);
    } }
  { float* tw = (float*)(ws + OFF_TW);
    for (size_t it = gt; it < (size_t)FN1 * FN2; it += gs) { const int s2 = (int)(it % FN2), k1 = (int)(it / FN2); float s, c; sincospif((float)(2 * k1 * s2) / (float)ST, &s, &c); tw[it * 2] = c; tw[it * 2 + 1] = -s; } }
  { float* cs = (float*)(ws + OFF_CS);
    for (size_t it = gt; it < (size_t)256 * 32; it += gs) { const int j = (int)(it & 31), pos = (int)(it >> 5); const float inv = powf(10000.f, -(float)(2 * j) / 64.f); const float ang = (float)pos * inv; cs[it * 2] = cosf(ang); cs[it * 2 + 1] = sinf(ang); } }
  { u32x4* kz = (u32x4*)(ws + OFF_K + (size_t)ST * 512); u32x4* vz = (u32x4*)(ws + OFF_V + (size_t)ST * 512); const u32x4 z = {0u, 0u, 0u, 0u};
    for (size_t it = gt; it < (size_t)(TPAD - ST) * 32; it += gs) { kz[it] = z; vz[it] = z; } }
  { const int lane = tl & 63, gw = blockIdx.x * 8 + (tl >> 6), nw = gridDim.x * 8;
    u16* hb = (u16*)(ws + OFF_HB); float* rstd = (float*)(ws + OFF_RSTD); float* hm = (float*)(ws + OFF_HMETA);
    for (int s0 = gw; s0 < ST; s0 += 2 * nw) {
      f32x4 v[2][4]; const int s1 = s0 + nw; const bool has1 = s1 < ST;
#pragma unroll
      for (int q = 0; q < 2; ++q) { const int s = q ? s1 : s0; if (q == 0 || has1) { const float* src = s < 16 ? p.meta + (size_t)s * 1024 : p.x + (size_t)(s - 16) * 1024;
#pragma unroll
          for (int i = 0; i < 4; ++i) v[q][i] = *(const f32x4*)(src + i * 256 + lane * 4); } }
#pragma unroll
      for (int q = 0; q < 2; ++q) { const int s = q ? s1 : s0; if (q == 0 || has1) { float ss = 0.f;
#pragma unroll
          for (int i = 0; i < 4; ++i) { const f32x4 x = v[q][i]; ss += x[0] * x[0] + x[1] * x[1] + x[2] * x[2] + x[3] * x[3];
            u32x2 w; w.x = cvtpk(x[0], x[1]); w.y = cvtpk(x[2], x[3]); *(u32x2*)(hb + (size_t)s * 1024 + i * 256 + lane * 4) = w;
            if (s < 16) *(f32x4*)(hm + (size_t)s * 1024 + i * 256 + lane * 4) = x; }
          ss = wave_sum(ss);
          if (lane == 0) rstd[s] = s < 16 ? 1.f : rsqrtf(ss * (1.f / 1024.f) + EPS); } }
    } }
}
template <class Epi> __device__ __forceinline__ void run_gemm_sub(PG8_LAS unsigned char* lds, const u16* A, const u16* Bt, int M, int N, int K, int G, int c, const Epi& E, int lda = 0) {
  asm volatile("" : "+s"(K)); asm volatile("" : "+s"(N)); asm volatile("" : "+s"(M));
  pg8::StaticOrder S; S.init(M, N, G, c);
  const unsigned long long pt = probe_t0();
  pg8::gemm_phase<Epi, pg8::StaticOrder, false>(lds, pg8::Gemm{A, Bt, M, N, K, lda}, S, E, nullptr);
  probe_spin(2, pt);
}
template <class Epi> __device__ __forceinline__ void run_gemm(PG8_LAS unsigned char* lds, const u16* A, const u16* Bt, int M, int N, int K, int rot, const Epi& E) {
  (void)rot; run_gemm_sub(lds, A, Bt, M, N, K, (int)gridDim.x, (int)blockIdx.x, E);
}
#define GSYNC() do { const unsigned long long pts = probe_t0(); xcd_barrier(xbar); probe_spin(64, pts); } while (0)
__global__ __launch_bounds__(512, 2) void fwd_megakernel(Params p) {
  extern __shared__ __attribute__((aligned(16))) unsigned char shm[];
  cg::grid_group grid = cg::this_grid();
  PG8_LAS unsigned char* lds3 = (PG8_LAS unsigned char*)shm; char* lds = (char*)shm;
  unsigned char* ws = p.ws;
  volatile LAS unsigned* xst = (volatile LAS unsigned*)(lds3 + 131072);
  if (threadIdx.x < 2) xst[threadIdx.x] = 0u;
  __syncthreads();
  const XcdBarrier xbar = xcd_barrier_post((unsigned*)(ws + OFF_BAR), xst);
  const int nw = gridDim.x * 8;
  u16* hb = (u16*)(ws + OFF_HB); float* ssqp = (float*)(ws + OFF_SSQ); float* rstd = (float*)(ws + OFF_RSTD); float* hmeta = (float*)(ws + OFF_HMETA);
  u16* tb = (u16*)(ws + OFF_T); u16* kb = (u16*)(ws + OFF_K); u16* vb = (u16*)(ws + OFF_V);
  u16* qb = (u16*)(ws + OFF_Q); u16* ag = (u16*)(ws + OFF_AG); u16* mb = ag; u16* gt = (u16*)(ws + OFF_GT);
  u16* msq = (u16*)(ws + OFF_MS); u16* msag = msq + 16 * 1024; u16* msog = msag + 16 * 1024; u16* msgt = msog + 16 * 1024;
  float* PM = (float*)(ws + OFF_PM); float* PL = (float*)(ws + OFF_PL); float* PO = (float*)(ws + OFF_PO);
  u16* ut = (u16*)(ws + OFF_UT); u16* yt = (u16*)(ws + OFF_YT); u16* wb = (u16*)(ws + OFF_WB); u16* fg = (u16*)(ws + OFF_FG);
  const u16* f1t = (const u16*)(ws + OFF_F1T); const u16* f2t = (const u16*)(ws + OFF_F2T); const float* tw = (const float*)(ws + OFF_TW); const float* cs = (const float*)(ws + OFF_CS);

  { const unsigned long long pt = probe_t0(); prep_phase(p, lds); probe_spin(1, pt); }
  grid.sync();


  for (int l = 0; l < 2; ++l) {
#define IDS() const int tid = ltid(), lane = tid & 63, wid = tid >> 6, gw = blockIdx.x * 8 + wid, mw = wid * gridDim.x + blockIdx.x, fwg = gridDim.x >= 256 ? 128 : 0, mhi = (int)blockIdx.x >= fwg ? wid * ((int)gridDim.x - fwg) + (int)blockIdx.x - fwg : (1 << 30), nhi = 8 * ((int)gridDim.x - fwg); (void)lane; (void)wid; (void)gw; (void)mw; (void)mhi; (void)nhi
    const u16* winT = (const u16*)(ws + OFF_WIN + l * SZ_WIN); const u16* wfpT = (const u16*)(ws + OFF_WFP + l * SZ_WFP);
    const u16* wapT = (const u16*)(ws + OFF_WAP + l * SZ_W1K); const u16* woT = (const u16*)(ws + OFF_WOUT + l * SZ_W1K); const u16* mmT = (const u16*)(ws + OFF_MMIX + l * SZ_MMIX);
    const float* bg = p.b_gate + l * 2048; const float* qg = p.q_g + l * 128; const float* kg = p.k_g + l * 128;

    { const unsigned long long ptp = probe_t0(); IDS();
      {
        const bool split = gridDim.x >= 256, lower = blockIdx.x < 128;
        const int Gs = split ? (lower ? 128 : (int)gridDim.x - 128) : (int)gridDim.x, cs_ = split && !lower ? (int)blockIdx.x - 128 : (int)blockIdx.x;
        const int Ns = split ? (lower ? 512 : 1024) : 1536, pn0 = split && !lower ? 2 : 0;
        EpiA E{tb, fg, kb, vb, pn0};
        run_gemm_sub(lds3, hb + 16 * 1024, winT + (size_t)pn0 * 256 * 1024, SEQ, Ns, 1024, Gs, cs_, E); }
      { float* sc = (float*)lds; float* rsl = sc + 2048 + 128;
        const bool msplit = gridDim.x >= 256; const int mt0 = msplit ? (blockIdx.x < 128 ? (int)blockIdx.x : (1 << 20)) : (int)blockIdx.x, mts = msplit ? 128 : (int)gridDim.x;
        if (mt0 < INW / 16) meta_rstd_wg(hmeta, sc + 2048, rsl);
        meta_gemm_wg<1024>(hb, winT, l == 0 ? INW : 1536, mt0, mts, sc, [&](int col, int r0, f32x4 acc) {
#pragma unroll
          for (int j = 0; j < 4; ++j) { const int s = r0 + j; const float vf = acc[j] * rsl[s]; const u16 v = f2bf(vf);
            if (col < 512) tb[(size_t)s * 512 + col] = v; else if (col < 1024) fg[(size_t)s * 512 + col - 512] = v;
            else if (col < 1280) kb[(size_t)s * 256 + col - 1024] = v; else if (col < 1536) vb[(size_t)s * 256 + col - 1280] = v;
            else if (col < 2560) msq[(size_t)s * 1024 + col - 1536] = v; else if (col < 3584) msag[(size_t)s * 1024 + col - 2560] = v;
            else msgt[(size_t)s * 2048 + col - 3584] = f2bf(sigm_f(vf + bg[col - 3584])); } }); }
      if (l > 0) for (int s = 16 + blockIdx.x * 512 + tid; s < ST; s += gridDim.x * 512) rstd[s] = rstd_from_ssqp(ssqp + (size_t)s * 16);
      probe_spin(128, ptp); }
    GSYNC();
    { IDS(); fval_transpose(tb, rstd, ut, lds);
      for (int idx = blockIdx.x * 512 + tid; idx < SEQ * 32; idx += gridDim.x * 512) { const int s = 16 + (idx >> 5); u32x4* vp = (u32x4*)(vb + (size_t)s * 256 + (idx & 31) * 8); const u32x4 w = *vp; const float rs = rstd[s];
        u32x4 o; o.x = cvtpk(rs * bflo(w.x), rs * bfhi(w.x)); o.y = cvtpk(rs * bflo(w.y), rs * bfhi(w.y)); o.z = cvtpk(rs * bflo(w.z), rs * bfhi(w.z)); o.w = cvtpk(rs * bflo(w.w), rs * bfhi(w.w)); *vp = o; } }
    GSYNC();
    { const unsigned long long ptp = probe_t0(); IDS(); EpiF1 E{tw, yt};
      run_gemm(lds3, f1t, ut, 512, 512 * FN2, 256, 0, E);
      fix_all<2>(kb, kg, cs, 0, ST, gw, nw, lane); if (l == 0) fix_all<8>(msq, qg, cs, 0, 16, gw >= 64 ? gw - 64 : gw + nw - 64, nw, lane); probe_spin(256, ptp); }
    GSYNC();
    { const unsigned long long ptp = probe_t0(); IDS(); EpiF2 E{wb}; run_gemm(lds3, f2t, yt, 256, FN1 * 512, 256, 0, E); probe_spin(512, ptp); }
    GSYNC();
#if PROBE_MASK & 65536
    xcd_barrier(xbar); xcd_barrier(xbar); xcd_barrier(xbar);
#endif
    { const unsigned long long ptp = probe_t0(); IDS();
#pragma unroll 1
      for (int pn = 0; pn < 2; ++pn) { EpiMix E{fg, rstd, tb, pn}; int c = (int)blockIdx.x - 64 * pn; if (c < 0) c += (int)gridDim.x;
        run_gemm_sub(lds3, wb + 16 * 1024 + pn * 512, mmT + (size_t)pn * 256 * 512, SEQ, 256, 512, (int)gridDim.x, c, E, 1024); }
      if (l == 0) meta_gemm_mix(wb, mmT, (int)blockIdx.x, (int)gridDim.x, (float*)lds, [&](int col, int r0, f32x4 acc) {
#pragma unroll
        for (int j = 0; j < 4; ++j) { const int s = r0 + j; tb[(size_t)s * 512 + col] = f2bf(acc[j] * silu_f(bf2f(fg[(size_t)s * 512 + col]))); } });
      { const unsigned long long ptm = probe_t0();
        if (l == 0) for (int j = (int)blockIdx.x >= fwg ? (int)blockIdx.x - fwg : (int)blockIdx.x - fwg + (int)gridDim.x; j < 128; j += gridDim.x) meta_attn_partial(j, msq, kb, vb, PM, PL, PO);
        probe_spin(8, ptm); } probe_spin(1024, ptp); }
    GSYNC();
    { const unsigned long long ptp = probe_t0(); IDS(); EpiE E{rstd, bg, qb, ag, gt};
      if (l == 0) for (int b = blockIdx.x; b < 128; b += gridDim.x) meta_attn_combine(b, PM, PL, PO, msag, msog, lds);
      run_gemm(lds3, hb + 16 * 1024, winT + (size_t)1536 * 1024, SEQ, 4096, 1024, 0, E);
      probe_spin(2048, ptp); }
    GSYNC();
    { const unsigned long long ptp = probe_t0(); IDS(); { const unsigned long long ptq = probe_t0(); fix_all<8>(qb, qg, cs, 16, ST, gw, nw, lane); probe_spin(32768, ptq); }
      GSYNC();
      const unsigned long long pta = probe_t0();
      if (__builtin_amdgcn_readfirstlane(threadIdx.x) >= 256) __builtin_amdgcn_s_setprio(1);
      for (int item = blockIdx.x; item < 512; item += gridDim.x) {
        const int h = item >> 6, blk = item & 63, s0 = 16 + blk * 256;
        u16* Qb = qb + (size_t)s0 * 1024 + h * 128;
        att::attn_body(Qb, kb + (h >> 2) * 128, vb + (h >> 2) * 128, Qb, ag + (size_t)s0 * 1024 + h * 128, lds);
      }
      __builtin_amdgcn_s_setprio(0);
      probe_spin(4, pta); probe_spin(4096, ptp); }
    GSYNC();
    { const unsigned long long ptp = probe_t0(); IDS(); EpiG<0> E0{gt, mb}; run_gemm(lds3, tb + 16 * 512, wfpT, SEQ, 1024, 512, 0, E0);
      EpiG<1> E1{gt, mb}; run_gemm(lds3, qb + 16 * 1024, wapT, SEQ, 1024, 1024, 0, E1);
      { float* sc = (float*)lds;
        if (l == 0) for (int tile = blockIdx.x; tile < 64; tile += gridDim.x) {
          f32x4 a1 = {0.f, 0.f, 0.f, 0.f}, a2 = {0.f, 0.f, 0.f, 0.f}; const int col = tile * 16 + (lane & 15), r0 = (lane >> 4) * 4;
          { const u16* ap = tb + (size_t)(lane & 15) * 512 + wid * 64 + 8 * (lane >> 4); const u16* bp = wfpT + (size_t)col * 512 + wid * 64 + 8 * (lane >> 4);
            const u16* ap2 = msog + (size_t)(lane & 15) * 1024 + wid * 128 + 8 * (lane >> 4); const u16* bp2 = wapT + (size_t)col * 1024 + wid * 128 + 8 * (lane >> 4);
            bf16x8 av[6], bv[6];
#pragma unroll
            for (int i = 0; i < 2; ++i) { av[i] = *(const bf16x8*)(ap + i * 32); bv[i] = *(const bf16x8*)(bp + i * 32); }
#pragma unroll
            for (int i = 0; i < 4; ++i) { av[2 + i] = *(const bf16x8*)(ap2 + i * 32); bv[2 + i] = *(const bf16x8*)(bp2 + i * 32); }
#pragma unroll
            for (int i = 0; i < 2; ++i) a1 = __builtin_amdgcn_mfma_f32_16x16x32_bf16(av[i], bv[i], a1, 0, 0, 0);
#pragma unroll
            for (int i = 0; i < 4; ++i) a2 = __builtin_amdgcn_mfma_f32_16x16x32_bf16(av[2 + i], bv[2 + i], a2, 0, 0, 0); }
          *(f32x4*)(sc + (wid * 64 + lane) * 4) = a1; *(f32x4*)(sc + 2048 + (wid * 64 + lane) * 4) = a2;
          __syncthreads();
          if (wid == 0) { f32x4 s1 = *(const f32x4*)(sc + lane * 4), s2 = *(const f32x4*)(sc + 2048 + lane * 4);
#pragma unroll
            for (int w = 1; w < 8; ++w) { s1 += *(const f32x4*)(sc + (w * 64 + lane) * 4); s2 += *(const f32x4*)(sc + 2048 + (w * 64 + lane) * 4); }
#pragma unroll
            for (int j = 0; j < 4; ++j) { const int s = r0 + j; mb[(size_t)s * 1024 + col] = f2bf(bf2f(msgt[(size_t)s * 2048 + col]) * s1[j] + bf2f(msgt[(size_t)s * 2048 + 1024 + col]) * s2[j]); } }
          __syncthreads();
        } } probe_spin(8192, ptp); }
    GSYNC();
    { const unsigned long long ptp = probe_t0(); IDS(); EpiH E{l == 0 ? p.x : p.out, p.out, hb, ssqp};
      run_gemm(lds3, mb + 16 * 1024, woT, SEQ, 1024, 1024, 0, E);
      if (l == 0) meta_gemm_wg<1024>(mb, woT, 1024, (int)blockIdx.x, (int)gridDim.x, (float*)lds, [&](int col, int r0, f32x4 acc) {
#pragma unroll
        for (int j = 0; j < 4; ++j) { const int s = r0 + j; const float v = hmeta[(size_t)s * 1024 + col] + acc[j]; hmeta[(size_t)s * 1024 + col] = v; hb[(size_t)s * 1024 + col] = f2bf(v); } }); probe_spin(16384, ptp); }
    if (l == 0) GSYNC();
  }
}

extern "C" void kernel_launch(void* const* d_in, const int* in_sizes, int n_in, void* d_out, int out_size, void* d_ws, size_t ws_size, hipStream_t stream) {
  static int grid_blocks = 0;
  if (grid_blocks == 0) {
    if (n_in != 11 || out_size != SEQ * DM || ws_size < OFF_XEND) { fprintf(stderr, "kernel_launch: unexpected shapes (n_in %d out %d ws %zu, need ws >= %zu)\n", n_in, out_size, ws_size, (size_t)OFF_XEND); grid_blocks = -1; return; }
    int dev = 0, cus = 0, per_cu = 0;
    (void)hipGetDevice(&dev); (void)hipDeviceGetAttribute(&cus, hipDeviceAttributeMultiprocessorCount, dev);
    if (hipFuncSetAttribute((const void*)fwd_megakernel, hipFuncAttributeMaxDynamicSharedMemorySize, LDS_BYTES) != hipSuccess) { fprintf(stderr, "kernel_launch: hipFuncSetAttribute failed\n"); grid_blocks = -1; return; }
    if (hipOccupancyMaxActiveBlocksPerMultiprocessor(&per_cu, (const void*)fwd_megakernel, 512, LDS_BYTES) != hipSuccess || per_cu < 1) { fprintf(stderr, "kernel_launch: occupancy query says %d blocks per CU\n", per_cu); (void)hipGetLastError(); per_cu = 1; }
    grid_blocks = cus * 1;
    fprintf(stderr, "kernel_launch: grid %d (cus %d, per_cu %d), ws %zu, need %zu\n", grid_blocks, cus, per_cu, ws_size, (size_t)OFF_XEND);
  }
  if (grid_blocks < 0) return;
  Params p{};
  p.x = (const float*)d_in[0]; p.meta = (const float*)d_in[1]; p.norm_g = (const float*)d_in[2]; p.w_in = (const float*)d_in[3]; p.b_gate = (const float*)d_in[4];
  p.q_g = (const float*)d_in[5]; p.k_g = (const float*)d_in[6]; p.w_fmix = (const float*)d_in[7]; p.w_fproj = (const float*)d_in[8]; p.w_aproj = (const float*)d_in[9]; p.w_out = (const float*)d_in[10];
  p.out = (float*)d_out; p.ws = (unsigned char*)d_ws;
  if (hipMemsetAsync((unsigned char*)d_ws + OFF_BAR, 0, 16384, stream) != hipSuccess) { fprintf(stderr, "kernel_launch: memset of the barrier words failed\n"); return; }
  void* args[] = {&p};
  const hipError_t e = hipLaunchCooperativeKernel((const void*)fwd_megakernel, dim3(grid_blocks), dim3(512), args, LDS_BYTES, stream);
  if (e != hipSuccess) fprintf(stderr, "kernel_launch: cooperative launch failed: %s (grid %d)\n", hipGetErrorString(e), grid_blocks);
}
```

```cpp
#include <hip/hip_runtime.h>
#include <hip/hip_bf16.h>
#include <hip/hip_cooperative_groups.h>
#include <cstdio>
namespace cg = cooperative_groups;
namespace pg8 {
#define PG8_LAS __attribute__((address_space(3)))
typedef unsigned short bf16_t;
typedef short bf16x8 __attribute__((ext_vector_type(8)));
typedef float f32x4 __attribute__((ext_vector_type(4)));
typedef unsigned u32x4 __attribute__((ext_vector_type(4)));
constexpr int BM = 256, BK = 64, HALF = 128, HTB = HALF * BK * 2  , STAGE_BYTES = 8 * HTB, NXCD = 8, WGM = 8;

__host__ __device__ __forceinline__ int lds_byte(int r, int c) { const int st = (r >> 4) * 2 + (c >> 5), rr = r & 15, cc = c & 31, ob = rr * 64 + cc * 2; return st * 1024 + (ob ^ (((ob >> 9) & 1) << 5)); }
__host__ __device__ __forceinline__ void stage_rc(int b, int& R, int& C) { const int st = b / 1024, sb = b % 1024, swz = sb ^ (((sb >> 9) & 1) << 5); R = (st >> 1) * 16 + swz / 64; C = (st & 1) * 32 + (swz % 64) / 2; }
__host__ __device__ __forceinline__ int perm32(int rho) { const int n = rho >> 4, i = rho & 15; return 8 * (i >> 2) + 4 * n + (i & 3); }

struct Unit { int pm, pn; };
struct Gemm { const bf16_t* A; const bf16_t* Bt; int M, N, K; int lda; };

struct StaticOrder {
    int nM, nN, nwg, G, c;
    __host__ __device__ void init(int M, int N, int G_, int c_) { nM = M / BM; nN = N / BM; nwg = nM * nN; G = G_; c = c_; }
    __host__ __device__ bool next(int i, Unit& u) const {
        const long L = (long)i * G + c; if (L >= nwg) return false;
        int wgid = (int)L; { const int q = nwg / NXCD, r = nwg % NXCD, xcd = wgid % NXCD, off = wgid / NXCD; wgid = (xcd < r ? xcd * (q + 1) : r * (q + 1) + (xcd - r) * q) + off; }
        const int nig = WGM * nN, gid = wgid / nig, fm = gid * WGM, gsz = (nM - fm) < WGM ? (nM - fm) : WGM;
        u.pm = fm + ((wgid % nig) % gsz); u.pn = (wgid % nig) / gsz; return true;
    }
    __device__ __forceinline__ void a_ready(const Unit&) const {}
    __device__ __forceinline__ void done(const Unit&) const {}
};
template <class Epi, class Sched, bool STAMP = false>
__device__ __forceinline__ void gemm_phase(PG8_LAS unsigned char* lds, const Gemm g, const Sched& S, const Epi& E, unsigned long long* stamps) {
    int tid_l = threadIdx.x; asm volatile("" : "+v"(tid_l));
    const int tid = tid_l, wid = __builtin_amdgcn_readfirstlane(tid >> 6), lane = tid & 63, wr = wid >> 2, wc = wid & 3, fr = lane & 15, fq = lane >> 4;
    const int K = g.K, nt = K / BK, lda = g.lda ? g.lda : K;
    int ts_lo = 0, ts_hi = 0, nts = 0; const unsigned long long rt_entry = STAMP ? (unsigned long long)wall_clock64() : 0ull;
#define PG8_STAMP() do { if (STAMP && wid == 0 && nts < 64) { const unsigned long long _c = (unsigned long long)clock64(); \
        ts_lo = (lane == nts) ? (int)(unsigned)_c : ts_lo; ts_hi = (lane == nts) ? (int)(unsigned)(_c >> 32) : ts_hi; ++nts; } } while (0)
    PG8_STAMP();
    unsigned voffA[2], voffB[2];
#pragma unroll
    for (int i = 0; i < 2; ++i) { int R, C; stage_rc(tid * 16 + i * 8192, R, C); const int Rb = Epi::PERM ? ((R & ~31) + perm32(R & 31)) : R;
        voffA[i] = (unsigned)(R * lda + C) * 2u; voffB[i] = (unsigned)(Rb * K + C) * 2u; }
    const size_t kstep = (size_t)(BK * 2);
    const size_t hstep = (size_t)HALF * K * 2;
    const size_t tstep = 2 * hstep;
    const size_t hstepA = (size_t)HALF * lda * 2, tstepA = 2 * hstepA;
    const unsigned ldsw = (unsigned)wid * 1024u;
    const int aoff = lds_byte(wr * 64 + fr, fq * 8), boff = lds_byte(wc * 32 + fr, fq * 8);
#define PG8_SA(b, h) (((b) * 2 + (h)) * HTB)
#define PG8_SB(b, h) ((4 + (b) * 2 + (h)) * HTB)
#define PG8_STAGE(bufoff, gbase, voff) do { _Pragma("unroll") for (int _i = 0; _i < 2; ++_i) \
        __builtin_amdgcn_global_load_lds((const unsigned*)((const char*)(gbase) + (voff)[_i]), (PG8_LAS unsigned*)(lds + (bufoff) + ldsw + _i * 8192), 16, 0, 0); } while (0)
#define PG8_LDA(dst, b, h) do { _Pragma("unroll") for (int m = 0; m < 4; ++m) _Pragma("unroll") for (int k = 0; k < 2; ++k) dst[m][k] = *(const PG8_LAS bf16x8*)(lds + PG8_SA(b, h) + aoff + m * 2048 + k * 1024); } while (0)
#define PG8_LDB(dst, b, h) do { _Pragma("unroll") for (int n = 0; n < 2; ++n) _Pragma("unroll") for (int k = 0; k < 2; ++k) dst[n][k] = *(const PG8_LAS bf16x8*)(lds + PG8_SB(b, h) + boff + n * 2048 + k * 1024); } while (0)
#define PG8_MMA(ai, bj, At, Bt) do { __builtin_amdgcn_s_setprio(1); _Pragma("unroll") for (int m = 0; m < 4; ++m) _Pragma("unroll") for (int n = 0; n < 2; ++n) _Pragma("unroll") for (int k = 0; k < 2; ++k) \
        acc[ai][bj][m][n] = __builtin_amdgcn_mfma_f32_16x16x32_bf16(Bt[n][k], At[m][k], acc[ai][bj][m][n], 0, 0, 0); __builtin_amdgcn_s_setprio(0); } while (0)
#define PG8_WAIT_V(n) asm volatile("s_waitcnt vmcnt(" #n ")" ::: "memory")
#define PG8_WAIT_L(n) asm volatile("s_waitcnt lgkmcnt(" #n ")" ::: "memory")
#define PG8_BAR __builtin_amdgcn_s_barrier()
#define PG8_SCHED __builtin_amdgcn_sched_barrier(0)
    Unit cur, nxt; int ui = 0;
    if (!S.next(0, cur)) return;
    f32x4 acc[2][2][4][2];
#pragma unroll
    for (int a = 0; a < 2; ++a)
#pragma unroll
        for (int b = 0; b < 2; ++b)
#pragma unroll
            for (int m = 0; m < 4; ++m)
#pragma unroll
                for (int n = 0; n < 2; ++n) acc[a][b][m][n] = (f32x4){0.f, 0.f, 0.f, 0.f};
    bf16x8 At[4][2], B0[2][2], B1[2][2];
    const char* cA = (const char*)g.A + (size_t)cur.pm * tstepA; const char* cB = (const char*)g.Bt + (size_t)cur.pn * tstep;
    S.a_ready(cur);
    PG8_STAGE(PG8_SB(0, 0), cB, voffB); PG8_STAGE(PG8_SA(0, 0), cA, voffA); PG8_STAGE(PG8_SB(0, 1), cB + hstep, voffB); PG8_STAGE(PG8_SA(0, 1), cA + hstepA, voffA);
    if (wr == 1) PG8_BAR;
    PG8_WAIT_V(4); PG8_BAR;
    PG8_STAGE(PG8_SB(1, 0), cB + kstep, voffB); PG8_STAGE(PG8_SA(1, 0), cA + kstep, voffA); PG8_STAGE(PG8_SB(1, 1), cB + hstep + kstep, voffB);
    PG8_WAIT_V(6); PG8_BAR;
    PG8_STAMP();
    for (;;) {
        const bool has_next = S.next(ui + 1, nxt);
        const char* nA = has_next ? (const char*)g.A + (size_t)nxt.pm * tstepA : cA; const char* nB = has_next ? (const char*)g.Bt + (size_t)nxt.pn * tstep : cB;
#pragma unroll 1
        for (int t = 0; t < nt; t += 2) {
            const bool last = (t == nt - 2);
            const char* a1 = cA + (size_t)(t + 1) * kstep;
            const char* a2 = last ? nA : cA + (size_t)(t + 2) * kstep; const char* b2 = last ? nB : cB + (size_t)(t + 2) * kstep;
            const char* a3 = a2 + kstep; const char* b3 = b2 + kstep;
            if (last && has_next) S.a_ready(nxt);
            PG8_LDB(B0, 0, 0); PG8_SCHED; PG8_LDA(At, 0, 0); PG8_STAGE(PG8_SA(1, 1), a1 + hstepA, voffA);
            PG8_WAIT_L(8); PG8_BAR; PG8_WAIT_L(0); PG8_MMA(0, 0, At, B0); PG8_BAR; PG8_SCHED;
            PG8_LDB(B1, 0, 1); PG8_STAGE(PG8_SB(0, 0), b2, voffB);
            PG8_BAR; PG8_WAIT_L(0); PG8_MMA(0, 1, At, B1); PG8_BAR;
            PG8_LDA(At, 0, 1); PG8_STAGE(PG8_SA(0, 0), a2, voffA);
            PG8_BAR; PG8_WAIT_L(0); PG8_MMA(1, 0, At, B0); PG8_BAR; PG8_SCHED;
            PG8_STAGE(PG8_SB(0, 1), b2 + hstep, voffB);
            PG8_WAIT_V(6); PG8_BAR; PG8_MMA(1, 1, At, B1); PG8_BAR;
            PG8_LDB(B0, 1, 0); PG8_SCHED; PG8_LDA(At, 1, 0); PG8_STAGE(PG8_SA(0, 1), a2 + hstepA, voffA);
            PG8_WAIT_L(8); PG8_BAR; PG8_WAIT_L(0); PG8_MMA(0, 0, At, B0); PG8_BAR; PG8_SCHED;
            PG8_LDB(B1, 1, 1); PG8_STAGE(PG8_SB(1, 0), b3, voffB);
            PG8_BAR; PG8_WAIT_L(0); PG8_MMA(0, 1, At, B1); PG8_BAR;
            PG8_LDA(At, 1, 1); PG8_STAGE(PG8_SA(1, 0), a3, voffA);
            PG8_BAR; PG8_WAIT_L(0); PG8_MMA(1, 0, At, B0); PG8_BAR; PG8_SCHED;
            PG8_STAGE(PG8_SB(1, 1), b3 + hstep, voffB);
            PG8_WAIT_V(6); PG8_BAR; PG8_MMA(1, 1, At, B1); PG8_BAR;
        }
        PG8_STAMP();
        if constexpr (!Epi::AFTER_DRAIN) { E(acc, cur, wr, wc, fr, fq); S.done(cur); }
        PG8_STAMP();
        if (!has_next) break;
#pragma unroll
        for (int a = 0; a < 2; ++a)
#pragma unroll
            for (int b = 0; b < 2; ++b)
#pragma unroll
                for (int m = 0; m < 4; ++m)
#pragma unroll
                    for (int n = 0; n < 2; ++n) acc[a][b][m][n] = (f32x4){0.f, 0.f, 0.f, 0.f};
        cur = nxt; cA = nA; cB = nB; ++ui;
    }
    PG8_WAIT_V(0);
    if (wr == 0) PG8_BAR;
    PG8_BAR;
    if constexpr (Epi::AFTER_DRAIN) { E.fused(acc, cur, wr, wc, fr, fq, lds, wid, lane); S.done(cur); }
    PG8_STAMP();
    if (STAMP && wid == 0) { stamps[lane] = lane < nts ? (((unsigned long long)(unsigned)ts_hi << 32) | (unsigned)ts_lo) : 0ull;
        if (lane == 62) stamps[62] = rt_entry; if (lane == 63) stamps[63] = (unsigned long long)wall_clock64(); }
#undef PG8_STAMP
#undef PG8_SA
#undef PG8_SB
#undef PG8_STAGE
#undef PG8_LDA
#undef PG8_LDB
#undef PG8_MMA
#undef PG8_WAIT_V
#undef PG8_WAIT_L
#undef PG8_BAR
#undef PG8_SCHED
}
}

typedef unsigned short u16;
using pg8::bf16x8; using pg8::f32x4; using pg8::u32x4;
typedef short s16x4 __attribute__((ext_vector_type(4)));
typedef float f32x16 __attribute__((ext_vector_type(16)));
typedef float f32x2 __attribute__((ext_vector_type(2)));
typedef unsigned u32x2 __attribute__((ext_vector_type(2)));

constexpr int DM = 1024, SEQ = 16384, NMETA = 16, ST = 16400, TPAD = 16512, INW = 5632;
constexpr int FN1 = 164, FN2 = 100;
constexpr float EPS = 1e-6f;
constexpr size_t SZ_WIN = (size_t)INW * DM * 2, SZ_WFP = (size_t)1024 * 512 * 2, SZ_W1K = (size_t)1024 * 1024 * 2, SZ_MMIX = (size_t)512 * 1024 * 2;
constexpr size_t OFF_WIN = 0, OFF_WFP = OFF_WIN + 2 * SZ_WIN, OFF_WAP = OFF_WFP + 2 * SZ_WFP, OFF_WOUT = OFF_WAP + 2 * SZ_W1K, OFF_MMIX = OFF_WOUT + 2 * SZ_W1K;
constexpr size_t OFF_F1T = OFF_MMIX + 2 * SZ_MMIX, OFF_F2T = OFF_F1T + 512 * 256 * 2, OFF_TW = OFF_F2T + 256 * 256 * 2, OFF_CS = OFF_TW + 131328;
constexpr size_t OFF_HB = OFF_CS + 65536, SZ_T1K = (size_t)TPAD * 1024 * 2, OFF_SSQ = OFF_HB + SZ_T1K, OFF_HMETA = OFF_SSQ + (size_t)ST * 16 * 4;
constexpr size_t OFF_RSTD = OFF_HMETA + 65536, OFF_BAR = OFF_RSTD + 65792, OFF_MS = OFF_BAR + 16384, OFF_PM = OFF_MS + 163840, OFF_PL = OFF_PM + 65536, OFF_PO = OFF_PL + 65536, OFF_T = OFF_PO + (size_t)8 * 128 * 16 * 128 * 4;
constexpr size_t SZ_T512 = (size_t)TPAD * 512 * 2, OFF_K = OFF_T + SZ_T512, SZ_T256 = (size_t)TPAD * 256 * 2, OFF_V = OFF_K + SZ_T256, OFF_X = OFF_V + SZ_T256;
constexpr size_t OFF_Q = OFF_X, OFF_AG = OFF_Q + SZ_T1K, OFF_GT = OFF_AG + SZ_T1K, OFF_XEND = OFF_GT + 2 * SZ_T1K;
constexpr size_t SZ_UT = (size_t)512 * FN2 * 256 * 2, SZ_YT = (size_t)FN1 * 512 * 256 * 2;
constexpr size_t OFF_UT = OFF_X, OFF_YT = OFF_UT + SZ_UT, OFF_WB = OFF_YT + SZ_YT, OFF_FG = OFF_WB + SZ_T1K, OFF_XEND2 = OFF_FG + SZ_T512;
static_assert(OFF_XEND2 <= OFF_XEND, "FFT buffers must fit in the X region");
static_assert(OFF_XEND <= (size_t)256 * 1024 * 1024, "workspace over 256 MiB");
constexpr int LDS_BYTES = 131072 + 1024;

struct Params { const float *x, *meta, *norm_g, *w_in, *b_gate, *q_g, *k_g, *w_fmix, *w_fproj, *w_aproj, *w_out; float* out; unsigned char* ws; };

#ifndef PROBE_MASK
#define PROBE_MASK 0
#endif
__device__ __forceinline__ unsigned long long probe_t0() { return PROBE_MASK ? __builtin_amdgcn_s_memrealtime() : 0ull; }
__device__ __forceinline__ void probe_spin(int bit, unsigned long long t0) {
  if (PROBE_MASK & bit) { const unsigned long long t1 = __builtin_amdgcn_s_memrealtime(), te = t1 + (t1 - t0); while (__builtin_amdgcn_s_memrealtime() < te) __builtin_amdgcn_s_sleep(4); }
}
__device__ __forceinline__ int ltid() { int t = threadIdx.x; asm volatile("" : "+v"(t)); return t; }
typedef __bf16 bf16v2 __attribute__((ext_vector_type(2)));
__device__ __forceinline__ unsigned cvtpk(float lo, float hi) { const f32x2 v = {lo, hi}; const bf16v2 b = __builtin_convertvector(v, bf16v2); return __builtin_bit_cast(unsigned, b); }
__device__ __forceinline__ u16 f2bf(float x) { return (u16)(cvtpk(x, 0.f) & 0xffffu); }
__device__ __forceinline__ float bf2f(u16 b) { return __uint_as_float(((unsigned)b) << 16); }
__device__ __forceinline__ float bflo(unsigned w) { return __uint_as_float(w << 16); }
__device__ __forceinline__ float bfhi(unsigned w) { return __uint_as_float(w & 0xffff0000u); }
__device__ __forceinline__ u32x4 pack8(f32x4 a, f32x4 b) { u32x4 w; w.x = cvtpk(a[0], a[1]); w.y = cvtpk(a[2], a[3]); w.z = cvtpk(b[0], b[1]); w.w = cvtpk(b[2], b[3]); return w; }
__device__ __forceinline__ float silu_f(float x) { return x * __builtin_amdgcn_rcpf(1.f + __expf(-x)); }
__device__ __forceinline__ float sigm_f(float x) { return __builtin_amdgcn_rcpf(1.f + __expf(-x)); }
__device__ __forceinline__ float wave_sum(float v) { for (int o = 32; o > 0; o >>= 1) v += __shfl_xor(v, o); return v; }
__device__ __forceinline__ float rstd_from_ssqp(const float* sp) {
  const f32x4 a = *(const f32x4*)sp, b = *(const f32x4*)(sp + 4), c = *(const f32x4*)(sp + 8), d = *(const f32x4*)(sp + 12);
  const float s = ((a[0] + a[1]) + (a[2] + a[3])) + ((b[0] + b[1]) + (b[2] + b[3])) + ((c[0] + c[1]) + (c[2] + c[3])) + ((d[0] + d[1]) + (d[2] + d[3]));
  return rsqrtf(s * (1.f / 1024.f) + EPS);
}
#define XB_TMO      128
#define XB_XCNT(j)  (256  + 64 * (j))
#define XB_XSUB(j)  (1280 + 64 * (j))
#define XB_XGEN(j)  (2304 + 64 * (j))
#define XB_TOP      3328
#define XB_TOPGEN   3392
#define XCD_BAR_WORDS 3456
#define XB_SPIN_CAP (1u << 18)
#define LAS __attribute__((address_space(3)))

__device__ __forceinline__ unsigned xb_ld(unsigned* p)              { return __hip_atomic_load(p, __ATOMIC_RELAXED, __HIP_MEMORY_SCOPE_AGENT); }
__device__ __forceinline__ unsigned xb_add(unsigned* p, unsigned v) { return __hip_atomic_fetch_add(p, v, __ATOMIC_RELAXED, __HIP_MEMORY_SCOPE_AGENT); }
__device__ __forceinline__ unsigned xb_xcc_id() { return (unsigned)__builtin_amdgcn_s_getreg((3 << 11) | 20) & 0xFu; }
#define XB_SPIN(cond, bar) do { unsigned _sp = 0; while (cond) { __builtin_amdgcn_s_sleep(1); \
    if ((++_sp & 255u) == 0u) { if (xb_ld(&(bar)[XB_TMO])) break; if (_sp > XB_SPIN_CAP) { atomicAdd(&(bar)[XB_TMO], 1u); break; } } } } while (0)

struct XcdBarrier {
    unsigned* bar; unsigned x;
    volatile LAS unsigned* st;
};

__device__ __forceinline__ XcdBarrier xcd_barrier_post(unsigned* bar, volatile LAS unsigned* st) {
    XcdBarrier b; b.bar = bar; b.x = xb_xcc_id(); b.st = st;
    if (threadIdx.x == 0) (void)xb_add(&bar[XB_XCNT(b.x)], 1u);
    return b;
}
__device__ __forceinline__ void xcd_barrier_complete(unsigned* bar, unsigned x, unsigned& nloc, unsigned& nx) {
    const unsigned G = gridDim.x * gridDim.y * gridDim.z;
    unsigned sum, cnt, mine, sp = 0u;
    for (;;) {
        sum = 0u; cnt = 0u; mine = 0u;
#pragma unroll
        for (unsigned j = 0; j < 16; ++j) { const unsigned c = xb_ld(&bar[XB_XCNT(j)]); sum += c; cnt += (c > 0u) ? 1u : 0u; mine = (j == x) ? c : mine; }
        if (sum == G) break;
        __builtin_amdgcn_s_sleep(1);
        if ((++sp & 255u) == 0u) { if (xb_ld(&bar[XB_TMO])) break; if (sp > XB_SPIN_CAP) { atomicAdd(&bar[XB_TMO], 1u); break; } }
    }
    nloc = mine > 0u ? mine : 1u; nx = cnt > 0u ? cnt : 1u;
}

__device__ __forceinline__ void xcd_barrier(const XcdBarrier& b) {
    asm volatile("s_waitcnt vmcnt(0)" ::: "memory");
    __syncthreads();
    if (threadIdx.x == 0) {
        unsigned* bar = b.bar;
        __builtin_amdgcn_s_waitcnt(0);
        unsigned nloc = b.st[0], nx = b.st[1];
        if (nloc == 0u) { xcd_barrier_complete(bar, b.x, nloc, nx); b.st[0] = nloc; b.st[1] = nx; }
        const unsigned old = xb_add(&bar[XB_XSUB(b.x)], 1u);
        const unsigned gen = old / nloc;
        if (old + 1u == (gen + 1u) * nloc) {
            __builtin_amdgcn_fence(__ATOMIC_RELEASE, "agent");
            asm volatile("s_waitcnt vmcnt(0)" ::: "memory");
            const unsigned og = xb_add(&bar[XB_TOP], 1u);
            const unsigned tg = og / nx;
            if (og + 1u == (tg + 1u) * nx) xb_add(&bar[XB_TOPGEN], 1u);
            else XB_SPIN(xb_ld(&bar[XB_TOPGEN]) == tg, bar);
            __builtin_amdgcn_fence(__ATOMIC_ACQUIRE, "agent");
            xb_add(&bar[XB_XGEN(b.x)], 1u);
            asm volatile("s_waitcnt vmcnt(0)" ::: "memory");
        } else {
            XB_SPIN(xb_ld(&bar[XB_XGEN(b.x)]) == gen, bar);
            __builtin_amdgcn_fence(__ATOMIC_ACQUIRE, "agent");
            asm volatile("s_waitcnt vmcnt(0)" ::: "memory");
        }
    }
    __syncthreads();
}

#define EPI_ROWS for (int ai = 0; ai < 2; ++ai) _Pragma("unroll") for (int m = 0; m < 4; ++m)
#define ROW_FENCE() do { asm volatile("" ::: "memory"); __builtin_amdgcn_sched_barrier(0); } while (0)
struct EpiA {
  static constexpr bool PERM = true, AFTER_DRAIN = false;
  u16 *fvn, *fg, *kb, *vb; int pn0;
  __device__ __forceinline__ void operator()(const f32x4 (&acc)[2][2][4][2], const pg8::Unit& u, int wr, int wc, int fr, int fq) const {
#pragma unroll
    EPI_ROWS {
      const int s = 16 + u.pm * 256 + ai * 128 + wr * 64 + m * 16 + fr;
#pragma unroll
      for (int bj = 0; bj < 2; ++bj) {
        const int pn = u.pn + pn0, col = pn * 256 + bj * 128 + wc * 32 + 8 * fq;
        u16* d = (pn < 2) ? fvn + (size_t)s * 512 + col : (pn < 4) ? fg + (size_t)s * 512 + (col - 512) : (pn == 4 ? kb + (size_t)s * 256 + (col - 1024) : vb + (size_t)s * 256 + (col - 1280));
        *(u32x4*)d = pack8(acc[ai][bj][m][0], acc[ai][bj][m][1]);
      }
    }
  }
};
struct EpiF1 {
  static constexpr bool PERM = false, AFTER_DRAIN = false;
  const float* tw; u16* yt;
  __device__ __forceinline__ void operator()(const f32x4 (&acc)[2][2][4][2], const pg8::Unit& u, int wr, int wc, int fr, int fq) const {
#pragma unroll
    for (int m = 0; m < 4; ++m) {
      const int k1 = u.pm * 128 + wr * 64 + m * 16 + fr;
      if (k1 < FN1) {
        f32x4 t0[2][2], t1[2][2]; int colx[2][2], s2[2][2];
#pragma unroll
        for (int bj = 0; bj < 2; ++bj)
#pragma unroll
          for (int n = 0; n < 2; ++n) { const int c0 = u.pn * 256 + bj * 128 + wc * 32 + n * 16 + 4 * fq; colx[bj][n] = c0 / FN2; s2[bj][n] = c0 - colx[bj][n] * FN2;
            const float* tp = tw + (size_t)(k1 * FN2 + s2[bj][n]) * 2; t0[bj][n] = *(const f32x4*)tp; t1[bj][n] = *(const f32x4*)(tp + 4); }
        __builtin_amdgcn_sched_barrier(0);
#pragma unroll
        for (int bj = 0; bj < 2; ++bj)
#pragma unroll
          for (int n = 0; n < 2; ++n) {
            const f32x4 re = acc[0][bj][m][n], im = acc[1][bj][m][n], a0 = t0[bj][n], a1 = t1[bj][n];
            const float yr0 = re[0] * a0[0] - im[0] * a0[1], yi0 = re[0] * a0[1] + im[0] * a0[0];
            const float yr1 = re[1] * a0[2] - im[1] * a0[3], yi1 = re[1] * a0[3] + im[1] * a0[2];
            const float yr2 = re[2] * a1[0] - im[2] * a1[1], yi2 = re[2] * a1[1] + im[2] * a1[0];
            const float yr3 = re[3] * a1[2] - im[3] * a1[3], yi3 = re[3] * a1[3] + im[3] * a1[2];
            u16* d = yt + ((size_t)k1 * 512 + colx[bj][n]) * 256 + s2[bj][n];
            u32x2 a; a.x = cvtpk(yr0, yr1); a.y = cvtpk(yr2, yr3); *(u32x2*)d = a;
            u32x2 b; b.x = cvtpk(yi0, yi1); b.y = cvtpk(yi2, yi3); *(u32x2*)(d + 128) = b;
          }
      }
    }
  }
};
struct EpiF2 {
  static constexpr bool PERM = true, AFTER_DRAIN = false;
  u16* wb;
  __device__ __forceinline__ void operator()(const f32x4 (&acc)[2][2][4][2], const pg8::Unit& u, int wr, int wc, int fr, int fq) const {
#pragma unroll
    EPI_ROWS {
      const int k2 = wr * 64 + m * 16 + fr;
      if (k2 < FN2) {
#pragma unroll
        for (int bj = 0; bj < 2; ++bj) {
          const int n = u.pn * 256 + bj * 128 + wc * 32 + 8 * fq, k1 = n >> 9, col = n & 511, g = col >> 7, c = col & 127;
          *(u32x4*)(wb + (size_t)(k1 + FN1 * k2) * 1024 + g * 256 + ai * 128 + c) = pack8(acc[ai][bj][m][0], acc[ai][bj][m][1]);
        }
      }
    }
  }
};
struct EpiMix {
  static constexpr bool PERM = true, AFTER_DRAIN = false;
  const u16* fg; const float* rstd; u16* t; int pn0;
  __device__ __forceinline__ void operator()(const f32x4 (&acc)[2][2][4][2], const pg8::Unit& u, int wr, int wc, int fr, int fq) const {
    const int col0 = (u.pn + pn0) * 256 + wc * 32 + 8 * fq;
#pragma unroll
    for (int ai = 0; ai < 2; ++ai) {
      const int s0 = 16 + u.pm * 256 + ai * 128 + wr * 64 + fr;
      u32x4 g[4][2]; float rs[4];
#pragma unroll
      for (int m = 0; m < 4; ++m) { rs[m] = rstd[s0 + m * 16];
#pragma unroll
        for (int bj = 0; bj < 2; ++bj) g[m][bj] = *(const u32x4*)(fg + (size_t)(s0 + m * 16) * 512 + col0 + bj * 128); }
      __builtin_amdgcn_sched_barrier(0);
#pragma unroll
      for (int m = 0; m < 4; ++m)
#pragma unroll
        for (int bj = 0; bj < 2; ++bj) { const u32x4 gg = g[m][bj]; const float r = rs[m]; f32x4 v0 = acc[ai][bj][m][0], v1 = acc[ai][bj][m][1];
          v0[0] *= silu_f(r * bflo(gg.x)); v0[1] *= silu_f(r * bfhi(gg.x)); v0[2] *= silu_f(r * bflo(gg.y)); v0[3] *= silu_f(r * bfhi(gg.y));
          v1[0] *= silu_f(r * bflo(gg.z)); v1[1] *= silu_f(r * bfhi(gg.z)); v1[2] *= silu_f(r * bflo(gg.w)); v1[3] *= silu_f(r * bfhi(gg.w));
          *(u32x4*)(t + (size_t)(s0 + m * 16) * 512 + col0 + bj * 128) = pack8(v0, v1); }
    }
  }
};
struct EpiE {
  static constexpr bool PERM = true, AFTER_DRAIN = false;
  const float* rstd; const float* bg; u16 *q, *ag, *gt;
  __device__ __forceinline__ void operator()(const f32x4 (&acc)[2][2][4][2], const pg8::Unit& u, int wr, int wc, int fr, int fq) const {
    float rsv[2][4];
#pragma unroll
    for (int ai = 0; ai < 2; ++ai)
#pragma unroll
      for (int m = 0; m < 4; ++m) rsv[ai][m] = rstd[16 + u.pm * 256 + ai * 128 + wr * 64 + m * 16 + fr];
#pragma unroll
    EPI_ROWS {
      const int s = 16 + u.pm * 256 + ai * 128 + wr * 64 + m * 16 + fr;
      const float rs = rsv[ai][m];
#pragma unroll
      for (int bj = 0; bj < 2; ++bj) {
        const int col = u.pn * 256 + bj * 128 + wc * 32 + 8 * fq;
        f32x4 v0 = acc[ai][bj][m][0] * rs, v1 = acc[ai][bj][m][1] * rs;
        if (u.pn < 4) *(u32x4*)(q + (size_t)s * 1024 + col) = pack8(v0, v1);
        else if (u.pn < 8) *(u32x4*)(ag + (size_t)s * 1024 + (col - 1024)) = pack8(v0, v1);
        else {
          const f32x4 b0 = *(const f32x4*)(bg + col - 2048), b1 = *(const f32x4*)(bg + col - 2048 + 4);
#pragma unroll
          for (int j = 0; j < 4; ++j) { v0[j] = sigm_f(v0[j] + b0[j]); v1[j] = sigm_f(v1[j] + b1[j]); }
          *(u32x4*)(gt + (size_t)s * 2048 + (col - 2048)) = pack8(v0, v1);
        }
      }
    }
  }
};
template <int SECOND> struct EpiG {
  static constexpr bool PERM = true, AFTER_DRAIN = false;
  const u16* gt; u16* mb;
  __device__ __forceinline__ void operator()(const f32x4 (&acc)[2][2][4][2], const pg8::Unit& u, int wr, int wc, int fr, int fq) const {
    const int col0 = u.pn * 256 + wc * 32 + 8 * fq;
#pragma unroll
    for (int ai = 0; ai < 2; ++ai) {
      const int s0 = 16 + u.pm * 256 + ai * 128 + wr * 64 + fr;
      u32x4 g[4][2], p[4][2];
#pragma unroll
      for (int m = 0; m < 4; ++m)
#pragma unroll
        for (int bj = 0; bj < 2; ++bj) { g[m][bj] = *(const u32x4*)(gt + (size_t)(s0 + m * 16) * 2048 + SECOND * 1024 + col0 + bj * 128);
          if (SECOND) p[m][bj] = *(const u32x4*)(mb + (size_t)(s0 + m * 16) * 1024 + col0 + bj * 128); }
      __builtin_amdgcn_sched_barrier(0);
#pragma unroll
      for (int m = 0; m < 4; ++m)
#pragma unroll
        for (int bj = 0; bj < 2; ++bj) { const u32x4 gg = g[m][bj]; f32x4 v0 = acc[ai][bj][m][0], v1 = acc[ai][bj][m][1];
          v0[0] *= bflo(gg.x); v0[1] *= bfhi(gg.x); v0[2] *= bflo(gg.y); v0[3] *= bfhi(gg.y); v1[0] *= bflo(gg.z); v1[1] *= bfhi(gg.z); v1[2] *= bflo(gg.w); v1[3] *= bfhi(gg.w);
          if (SECOND) { const u32x4 pp = p[m][bj]; v0[0] += bflo(pp.x); v0[1] += bfhi(pp.x); v0[2] += bflo(pp.y); v0[3] += bfhi(pp.y); v1[0] += bflo(pp.z); v1[1] += bfhi(pp.z); v1[2] += bflo(pp.w); v1[3] += bfhi(pp.w); }
          *(u32x4*)(mb + (size_t)(s0 + m * 16) * 1024 + col0 + bj * 128) = pack8(v0, v1); }
    }
  }
};
struct EpiH {
  static constexpr bool PERM = true, AFTER_DRAIN = false;
  const float* hin; float* hout; u16* hb; float* ssqp;
  __device__ __forceinline__ void operator()(const f32x4 (&acc)[2][2][4][2], const pg8::Unit& u, int wr, int wc, int fr, int fq) const {
    const int col0 = u.pn * 256 + wc * 32 + 8 * fq;
#pragma unroll
    for (int ai = 0; ai < 2; ++ai) {
      const int r0 = u.pm * 256 + ai * 128 + wr * 64 + fr;
      f32x4 h0[4][2], h1[4][2];
#pragma unroll
      for (int m = 0; m < 4; ++m)
#pragma unroll
        for (int bj = 0; bj < 2; ++bj) { const float* hp = hin + (size_t)(r0 + m * 16) * 1024 + col0 + bj * 128; h0[m][bj] = *(const f32x4*)hp; h1[m][bj] = *(const f32x4*)(hp + 4); }
      __builtin_amdgcn_sched_barrier(0);
#pragma unroll
      for (int m = 0; m < 4; ++m) { const int r = r0 + m * 16; float ss = 0.f;
#pragma unroll
        for (int bj = 0; bj < 2; ++bj) {
          const f32x4 v0 = acc[ai][bj][m][0] + h0[m][bj], v1 = acc[ai][bj][m][1] + h1[m][bj];
          float* op = hout + (size_t)r * 1024 + col0 + bj * 128; *(f32x4*)op = v0; *(f32x4*)(op + 4) = v1;
          *(u32x4*)(hb + (size_t)(16 + r) * 1024 + col0 + bj * 128) = pack8(v0, v1);
#pragma unroll
          for (int j = 0; j < 4; ++j) ss += v0[j] * v0[j] + v1[j] * v1[j];
        }
        ss += __shfl_xor(ss, 16); ss += __shfl_xor(ss, 32);
        if (fq == 0) ssqp[(size_t)(16 + r) * 16 + u.pn * 4 + wc] = ss; }
    }
  }
};
__device__ __forceinline__ void fix_rows4(u16* p  , const float* g, int s, bool valid, const float* cs, int lane) {
  const int c = lane & 15;
  u32x4 w = {0u, 0u, 0u, 0u}; if (valid) w = *(const u32x4*)(p + c * 8);
  float x[8] = {bflo(w.x), bfhi(w.x), bflo(w.y), bfhi(w.y), bflo(w.z), bfhi(w.z), bflo(w.w), bfhi(w.w)};
  float ss = 0.f;
#pragma unroll
  for (int i = 0; i < 8; ++i) ss += x[i] * x[i];
  ss += __shfl_xor(ss, 1); ss += __shfl_xor(ss, 2); ss += __shfl_xor(ss, 4); ss += __shfl_xor(ss, 8);
  const float rs = rsqrtf(ss * (1.f / 128.f) + EPS);
  const f32x4 g0 = *(const f32x4*)(g + c * 8), g1 = *(const f32x4*)(g + c * 8 + 4);
  float y[8], py[8];
#pragma unroll
  for (int i = 0; i < 4; ++i) { y[i] = x[i] * rs * g0[i]; y[4 + i] = x[4 + i] * rs * g1[i]; }
#pragma unroll
  for (int i = 0; i < 8; ++i) py[i] = __shfl_xor(y[i], 4);
  if (s >= 16) {
    const int t = s - 16, pos = (c < 8) ? (t >> 6) : (t & 63); const float* cp = cs + (size_t)(pos * 32 + (c & 3) * 8) * 2;
    const float sg = (c & 4) ? 1.f : -1.f;
#pragma unroll
    for (int i = 0; i < 4; ++i) { const f32x4 v = *(const f32x4*)(cp + i * 4);
      y[2 * i] = y[2 * i] * v[0] + sg * py[2 * i] * v[1]; y[2 * i + 1] = y[2 * i + 1] * v[2] + sg * py[2 * i + 1] * v[3]; }
  }
  if (valid) { u32x4 o; o.x = cvtpk(y[0], y[1]); o.y = cvtpk(y[2], y[3]); o.z = cvtpk(y[4], y[5]); o.w = cvtpk(y[6], y[7]); *(u32x4*)(p + c * 8) = o; }
}
template <int NH> __device__ __forceinline__ void fix_all(u16* buf, const float* g, const float* cs, int s_lo, int s_hi, int gw, int nw, int lane) {
  const int sub = lane >> 4, n = (s_hi - s_lo) * NH;
  for (int base = gw * 4; base < n; base += nw * 4) { const int idx = base + sub; const bool valid = idx < n; const int s = s_lo + idx / NH, hh = idx % NH;
    fix_rows4(buf + (size_t)s * (NH * 128) + hh * 128, g, s, valid, cs, lane); }
}

namespace att {
constexpr int D = 128, NW = 8, QBLK = 32, KVBLK = 64, LDQ = 1024, LDK = 256, LDO = 1024, KVALID = ST, NT = TPAD / KVBLK;
constexpr float SCALE = 0.088388347648318440f, THR = 8.f;
constexpr size_t SHM_V = KVBLK * D * 2, SHM_K = KVBLK * D * 2;
#define KSWZ(row, colB) ((row) * 256 + ((colB) ^ (((row) & 7) << 4)))
#define SBAR() __builtin_amdgcn_sched_barrier(0)
__device__ __forceinline__ int crow(int r, int hi) { return (r & 3) + 8 * (r >> 2) + 4 * hi; }
template <int MODE>
__device__ __forceinline__ void partialSM(f32x16& p0, f32x16& p1, float& m_reg, float& mn, float& alpha) {
  constexpr float C = SCALE * 1.4426950408889634f;
  if (MODE == 1) {
#pragma unroll
    for (int r = 8; r < 16; ++r) p0[r] = -1e30f;
  }
  if (MODE == 2) {
#pragma unroll
    for (int r = 0; r < 16; ++r) p0[r] = -1e30f;
  }
  if (MODE >= 1) {
#pragma unroll
    for (int r = 0; r < 16; ++r) p1[r] = -1e30f;
  }
  float pmax = p0[0];
#pragma unroll
  for (int r = 1; r < 16; ++r) pmax = fmaxf(pmax, p0[r]);
#pragma unroll
  for (int r = 0; r < 16; ++r) pmax = fmaxf(pmax, p1[r]);
  { auto rr = __builtin_amdgcn_permlane32_swap(__float_as_uint(pmax), __float_as_uint(pmax), false, false);
    pmax = fmaxf(__uint_as_float(rr[0]), __uint_as_float(rr[1])); }
  if (__builtin_expect(__all(pmax - m_reg <= THR / SCALE), 1)) { mn = m_reg; alpha = 1.f; }
  else { mn = fmaxf(m_reg, pmax); alpha = __builtin_amdgcn_exp2f((m_reg - mn) * C); m_reg = mn; }
  const float mnC = -mn * C;
#pragma unroll
  for (int r = 0; r < 16; ++r) p0[r] = fmaf(p0[r], C, mnC);
#pragma unroll
  for (int r = 0; r < 16; ++r) p1[r] = fmaf(p1[r], C, mnC);
#pragma unroll
  for (int r = 0; r < 16; ++r) p0[r] = __builtin_amdgcn_exp2f(p0[r]);
}
__device__ __forceinline__ void finishSM(f32x16& p0, f32x16& p1, float alpha, float& l_reg, bf16x8& pa0, bf16x8& pa1, bf16x8& pa2, bf16x8& pa3) {
#pragma unroll
  for (int r = 0; r < 16; ++r) p1[r] = __builtin_amdgcn_exp2f(p1[r]);
  float ps = 0;
#pragma unroll
  for (int r = 0; r < 16; ++r) ps += p0[r];
#pragma unroll
  for (int r = 0; r < 16; ++r) ps += p1[r];
  { auto rr = __builtin_amdgcn_permlane32_swap(__float_as_uint(ps), __float_as_uint(ps), false, false);
    ps = __uint_as_float(rr[0]) + __uint_as_float(rr[1]); }
  l_reg = l_reg * alpha + ps;
#define PK4(P, BASE, OUT) do { unsigned a0 = cvtpk(P[BASE + 0], P[BASE + 1]), a1 = cvtpk(P[BASE + 2], P[BASE + 3]);   \
    unsigned b0 = cvtpk(P[BASE + 4], P[BASE + 5]), b1 = cvtpk(P[BASE + 6], P[BASE + 7]);                              \
    auto r0 = __builtin_amdgcn_permlane32_swap(a0, b0, false, false); auto r1 = __builtin_amdgcn_permlane32_swap(a1, b1, false, false); \
    u32x4 w = {r0[0], r1[0], r0[1], r1[1]}; OUT = *reinterpret_cast<bf16x8*>(&w); } while (0)
  PK4(p0, 0, pa0); PK4(p0, 8, pa1); PK4(p1, 0, pa2); PK4(p1, 8, pa3);
#undef PK4
}
__device__ __forceinline__ void qkt(f32x16& p0, f32x16& p1, const char* Ks, const bf16x8* qr, int r32, int hi) {
  p0 = f32x16{}; p1 = f32x16{};
#pragma unroll
  for (int d0 = 0; d0 < 8; ++d0) { const int cb = (d0 * 16 + hi * 8) * 2;
    const bf16x8 b0 = *reinterpret_cast<const bf16x8*>(Ks + KSWZ(r32, cb));
    const bf16x8 b1 = *reinterpret_cast<const bf16x8*>(Ks + KSWZ(32 + r32, cb));
    p0 = __builtin_amdgcn_mfma_f32_32x32x16_bf16(b0, qr[d0], p0, 0, 0, 0);
    p1 = __builtin_amdgcn_mfma_f32_32x32x16_bf16(b1, qr[d0], p1, 0, 0, 0); }
}
__device__ __forceinline__ int v_st(int k, int c) { const int kk = (k & ~0xC) | ((k & 4) << 1) | ((k & 8) >> 1); return ((kk >> 3) * 4 + (c >> 5)) * 512 + ((kk & 7) * 32 + (c & 31)) * 2; }
__device__ __forceinline__ int v_rd_base(int lane) { return ((lane & 3) << 3) | (((lane >> 2) & 3) << 6) | (((lane >> 4) & 1) << 5) | (((lane >> 5) & 1) << 8); }
constexpr int v_rd_off(int d0, int ks, int half) { return d0 * 512 + ks * 4096 + half * 2048; }
template <int OFF> __device__ __forceinline__ s16x4 tr_read(int vb) {
  s16x4 r; asm volatile("ds_read_b64_tr_b16 %0, %1 offset:%2" : "=&v"(r) : "v"(vb), "i"(OFF) : "memory"); return r;
}
template <int D0> __device__ __forceinline__ void pv_one(f32x16& od, int vb, bf16x8 pa0, bf16x8 pa1, bf16x8 pa2, bf16x8 pa3) {
  const s16x4 l0 = tr_read<v_rd_off(D0, 0, 0)>(vb), h0 = tr_read<v_rd_off(D0, 0, 1)>(vb), l1 = tr_read<v_rd_off(D0, 1, 0)>(vb), h1 = tr_read<v_rd_off(D0, 1, 1)>(vb);
  const s16x4 l2 = tr_read<v_rd_off(D0, 2, 0)>(vb), h2 = tr_read<v_rd_off(D0, 2, 1)>(vb), l3 = tr_read<v_rd_off(D0, 3, 0)>(vb), h3 = tr_read<v_rd_off(D0, 3, 1)>(vb);
  asm volatile("s_waitcnt lgkmcnt(0)" ::: "memory"); SBAR();
#define PK(L, H) (bf16x8){L[0], L[1], L[2], L[3], H[0], H[1], H[2], H[3]}
  od = __builtin_amdgcn_mfma_f32_32x32x16_bf16(pa0, PK(l0, h0), od, 0, 0, 0);
  od = __builtin_amdgcn_mfma_f32_32x32x16_bf16(pa1, PK(l1, h1), od, 0, 0, 0);
  od = __builtin_amdgcn_mfma_f32_32x32x16_bf16(pa2, PK(l2, h2), od, 0, 0, 0);
  od = __builtin_amdgcn_mfma_f32_32x32x16_bf16(pa3, PK(l3, h3), od, 0, 0, 0);
#undef PK
}
__device__ __forceinline__ void pv_d0(f32x16* o, int vb, bf16x8 pa0, bf16x8 pa1, bf16x8 pa2, bf16x8 pa3) {
  pv_one<0>(o[0], vb, pa0, pa1, pa2, pa3); pv_one<1>(o[1], vb, pa0, pa1, pa2, pa3); pv_one<2>(o[2], vb, pa0, pa1, pa2, pa3); pv_one<3>(o[3], vb, pa0, pa1, pa2, pa3);
}
template <int MODE>
__device__ __forceinline__ void pv_sm(f32x16* o, int vb, bf16x8 pa0, bf16x8 pa1, bf16x8 pa2, bf16x8 pa3, f32x16& p0, f32x16& p1, float& m_reg, float& mn, float& alpha) {
  constexpr float C = SCALE * 1.4426950408889634f;
  pv_one<0>(o[0], vb, pa0, pa1, pa2, pa3);
  if (MODE == 1) {
#pragma unroll
    for (int r = 8; r < 16; ++r) p0[r] = -1e30f;
  }
  if (MODE == 2) {
#pragma unroll
    for (int r = 0; r < 16; ++r) p0[r] = -1e30f;
  }
  if (MODE >= 1) {
#pragma unroll
    for (int r = 0; r < 16; ++r) p1[r] = -1e30f;
  }
  float pmax = p0[0];
#pragma unroll
  for (int r = 1; r < 16; ++r) pmax = fmaxf(pmax, p0[r]);
  pv_one<1>(o[1], vb, pa0, pa1, pa2, pa3);
#pragma unroll
  for (int r = 0; r < 16; ++r) pmax = fmaxf(pmax, p1[r]);
  { auto rr = __builtin_amdgcn_permlane32_swap(__float_as_uint(pmax), __float_as_uint(pmax), false, false);
    pmax = fmaxf(__uint_as_float(rr[0]), __uint_as_float(rr[1])); }
  if (__builtin_expect(__all(pmax - m_reg <= THR / SCALE), 1)) { mn = m_reg; alpha = 1.f; }
  else { mn = fmaxf(m_reg, pmax); alpha = __builtin_amdgcn_exp2f((m_reg - mn) * C); m_reg = mn; }
  const float mnC = -mn * C;
  pv_one<2>(o[2], vb, pa0, pa1, pa2, pa3);
#pragma unroll
  for (int r = 0; r < 16; ++r) p0[r] = fmaf(p0[r], C, mnC);
#pragma unroll
  for (int r = 0; r < 16; ++r) p1[r] = fmaf(p1[r], C, mnC);
  pv_one<3>(o[3], vb, pa0, pa1, pa2, pa3);
#pragma unroll
  for (int r = 0; r < 16; ++r) p0[r] = __builtin_amdgcn_exp2f(p0[r]);
}

__device__ __forceinline__ void attn_body(const u16* __restrict__ Qb, const u16* __restrict__ Kh, const u16* __restrict__ Vh, u16* Ob, const u16* __restrict__ Gb, char* lds) {
  const int tid = ltid(), wid = tid >> 6, lane = tid & 63, r32 = lane & 31, hi = lane >> 5;
  char* V_lds = lds; char* K_lds = lds + 2 * SHM_V;
  float* ws = (float*)(lds + 2 * SHM_V + 2 * SHM_K) + wid * 64; float* li_l = ws; float* al_l = ws + 32;
  float m_reg = -1e30f, l_reg = 0; f32x16 o[4] = {}; bf16x8 qr[8];
  const u16* Qw = Qb + (long)(wid * QBLK + r32) * LDQ + hi * 8;
#pragma unroll
  for (int d0 = 0; d0 < 8; ++d0) qr[d0] = *reinterpret_cast<const bf16x8*>(Qw + d0 * 16);
  const int sr = tid >> 4, sc = (tid & 15) * 8, vst0 = v_st(sr, sc), vst1 = v_st(32 + sr, sc);
  const int vb0 = (int)(uintptr_t)V_lds + v_rd_base(lane);
  bf16x8 e_vs0, e_vs1, e_ks0, e_ks1, o_vs0, o_vs1, o_ks0, o_ks1;
#define SLOAD_E(k0) do { e_vs0 = *(const bf16x8*)&Vh[(long)((k0) + sr) * LDK + sc]; e_vs1 = *(const bf16x8*)&Vh[(long)((k0) + 32 + sr) * LDK + sc]; \
    e_ks0 = *(const bf16x8*)&Kh[(long)((k0) + sr) * LDK + sc]; e_ks1 = *(const bf16x8*)&Kh[(long)((k0) + 32 + sr) * LDK + sc]; } while (0)
#define SLOAD_O(k0) do { o_vs0 = *(const bf16x8*)&Vh[(long)((k0) + sr) * LDK + sc]; o_vs1 = *(const bf16x8*)&Vh[(long)((k0) + 32 + sr) * LDK + sc]; \
    o_ks0 = *(const bf16x8*)&Kh[(long)((k0) + sr) * LDK + sc]; o_ks1 = *(const bf16x8*)&Kh[(long)((k0) + 32 + sr) * LDK + sc]; } while (0)
#define SWRITE(b, P) do { *(bf16x8*)(V_lds + (b) * SHM_V + vst0) = P##_vs0; *(bf16x8*)(V_lds + (b) * SHM_V + vst1) = P##_vs1; const int kc = sc * 2; \
    *(bf16x8*)(K_lds + (b) * SHM_K + KSWZ(sr, kc)) = P##_ks0; *(bf16x8*)(K_lds + (b) * SHM_K + KSWZ(32 + sr, kc)) = P##_ks1; } while (0)
#define SWAIT() asm volatile("s_waitcnt vmcnt(4)" ::: "memory")
#define RESC(a) do { if (__any((a) < 1.f)) { if (hi == 0) al_l[r32] = (a); asm volatile("s_waitcnt lgkmcnt(0)" ::: "memory"); \
    _Pragma("unroll") for (int d = 0; d < 4; ++d) _Pragma("unroll") for (int r = 0; r < 16; ++r) o[d][r] *= al_l[crow(r, hi)]; } } while (0)
  f32x16 pA0, pA1, pB0, pB1; float mnA, mnB, alA, alB; bf16x8 pa0, pa1, pa2, pa3;
#define ITER(J, MB, MA, LOADE) do { \
    SBAR(); qkt(pB0, pB1, K_lds + SHM_K, qr, r32, hi); \
    finishSM(pA0, pA1, alA, l_reg, pa0, pa1, pa2, pa3); SBAR(); \
    SLOAD_O(((J) + 2) * KVBLK); SBAR(); \
    pv_sm<MB>(o, vb0, pa0, pa1, pa2, pa3, pB0, pB1, m_reg, mnB, alB); \
    __syncthreads(); SWAIT(); SWRITE(0, e); \
    RESC(alB); __syncthreads(); \
    SBAR(); qkt(pA0, pA1, K_lds, qr, r32, hi); \
    finishSM(pB0, pB1, alB, l_reg, pa0, pa1, pa2, pa3); SBAR(); \
    if (LOADE) SLOAD_E(((J) + 3) * KVBLK); SBAR(); \
    pv_sm<MA>(o, vb0 + (int)SHM_V, pa0, pa1, pa2, pa3, pA0, pA1, m_reg, mnA, alA); \
    __syncthreads(); SWAIT(); SWRITE(1, o); \
    RESC(alA); __syncthreads(); } while (0)
  SLOAD_E(0); asm volatile("s_waitcnt vmcnt(0)" ::: "memory"); SWRITE(0, e); __syncthreads();
  qkt(pA0, pA1, K_lds, qr, r32, hi); partialSM<0>(pA0, pA1, m_reg, mnA, alA);
  SLOAD_O(KVBLK); SLOAD_E(2 * KVBLK);
  SWAIT(); SWRITE(1, o); __syncthreads();
#pragma unroll 1
  for (int j = 1; j < NT - 3; j += 2) ITER(j, 0, 0, 1);
  ITER(NT - 3, 0, 1, 0);
  SBAR(); qkt(pB0, pB1, K_lds + SHM_K, qr, r32, hi);
  finishSM(pA0, pA1, alA, l_reg, pa0, pa1, pa2, pa3); SBAR();
  pv_sm<2>(o, vb0, pa0, pa1, pa2, pa3, pB0, pB1, m_reg, mnB, alB);
  __syncthreads(); RESC(alB);
  finishSM(pB0, pB1, alB, l_reg, pa0, pa1, pa2, pa3); SBAR();
  pv_d0(o, vb0 + (int)SHM_V, pa0, pa1, pa2, pa3);
  __syncthreads();
  if (hi == 0) li_l[r32] = l_reg; asm volatile("s_waitcnt lgkmcnt(0)" ::: "memory");
  { char* Ow = lds + wid * 8192;
#pragma unroll
    for (int r = 0; r < 16; ++r) { const int orow = crow(r, hi); const float rl = __builtin_amdgcn_rcpf(li_l[orow]);
#pragma unroll
      for (int d0 = 0; d0 < 4; ++d0) *(u16*)(Ow + orow * 256 + (d0 * 32 + r32) * 2) = f2bf(o[d0][r] * rl); }
    asm volatile("s_waitcnt lgkmcnt(0)" ::: "memory");
#pragma unroll
    for (int i = 0; i < 8; ++i) { const int id = i * 64 + lane, row = id >> 4, ch = id & 15;
      const u32x4 ov = *(const u32x4*)(Ow + row * 256 + ch * 16); const long gi = (long)(wid * QBLK + row) * LDO + ch * 8; const u32x4 g = *(const u32x4*)(Gb + gi);
      u32x4 w; w.x = cvtpk(bflo(ov.x) * silu_f(bflo(g.x)), bfhi(ov.x) * silu_f(bfhi(g.x))); w.y = cvtpk(bflo(ov.y) * silu_f(bflo(g.y)), bfhi(ov.y) * silu_f(bfhi(g.y)));
      w.z = cvtpk(bflo(ov.z) * silu_f(bflo(g.z)), bfhi(ov.z) * silu_f(bfhi(g.z))); w.w = cvtpk(bflo(ov.w) * silu_f(bflo(g.w)), bfhi(ov.w) * silu_f(bfhi(g.w)));
      *(u32x4*)(Ob + gi) = w; } }
  __syncthreads();
#undef ITER
#undef SLOAD_E
#undef SLOAD_O
#undef SWRITE
#undef SWAIT
#undef RESC
}
}
__device__ __forceinline__ float block_reduce(float v, float* red, bool is_max) {
  const int tl = ltid(), lane = tl & 63, wid = tl >> 6;
  for (int o = 32; o > 0; o >>= 1) { const float t = __shfl_xor(v, o); v = is_max ? fmaxf(v, t) : v + t; }
  __syncthreads();
  if (lane == 0) red[wid] = v;
  __syncthreads();
  float r = red[0];
  for (int i = 1; i < 8; ++i) r = is_max ? fmaxf(r, red[i]) : r + red[i];
  return r;
}
__device__ void meta_attn_partial(int j, const u16* msq, const u16* kb, const u16* vb, float* PM, float* PL, float* PO) {
  const int tid = ltid(), lane = tid & 63, wid = tid >> 6, g = lane >> 4, li = lane & 15;
  const int kvh = j & 1, c = j >> 1, half = wid >> 2, h = kvh * 4 + (wid & 3), step0 = c * 8 + half * 4, nsteps = 4 + ((c == 63 && half == 1) ? 1 : 0);
  bf16x8 qf[4];
#pragma unroll
  for (int ks = 0; ks < 4; ++ks) qf[ks] = *(const bf16x8*)(msq + (size_t)li * 1024 + h * 128 + ks * 32 + g * 8);
  f32x4 o[8];
#pragma unroll
  for (int db = 0; db < 8; ++db) o[db] = (f32x4){0.f, 0.f, 0.f, 0.f};
  float m_run = -1e30f, l_run = 0.f;
  for (int st = 0; st < nsteps; ++st) {
    const int key0 = (step0 + st) * 32;
    f32x4 s0 = {0.f, 0.f, 0.f, 0.f}, s1 = {0.f, 0.f, 0.f, 0.f};
    const u16* kp = kb + (size_t)(key0 + li) * 256 + kvh * 128 + g * 8;
    bf16x8 k0[4], k1[4];
#pragma unroll
    for (int ks = 0; ks < 4; ++ks) { k0[ks] = *(const bf16x8*)(kp + ks * 32); k1[ks] = *(const bf16x8*)(kp + 16 * 256 + ks * 32); }
    const u16* vp = vb + (size_t)(key0 + 4 * g) * 256 + kvh * 128 + li;
    u32x4 vw[8];
#pragma unroll
    for (int db = 0; db < 8; ++db) { const u16* q = vp + db * 16;
      vw[db].x = (unsigned)q[0] | ((unsigned)q[256] << 16); vw[db].y = (unsigned)q[512] | ((unsigned)q[768] << 16);
      vw[db].z = (unsigned)q[16 * 256] | ((unsigned)q[17 * 256] << 16); vw[db].w = (unsigned)q[18 * 256] | ((unsigned)q[19 * 256] << 16); }
#pragma unroll
    for (int ks = 0; ks < 4; ++ks) { s0 = __builtin_amdgcn_mfma_f32_16x16x32_bf16(k0[ks], qf[ks], s0, 0, 0, 0); s1 = __builtin_amdgcn_mfma_f32_16x16x32_bf16(k1[ks], qf[ks], s1, 0, 0, 0); }
    float mx = -1e30f;
#pragma unroll
    for (int r = 0; r < 4; ++r) { float a = s0[r] * att::SCALE; if (key0 + 4 * g + r >= ST) a = -1e30f; s0[r] = a; mx = fmaxf(mx, a);
      float b = s1[r] * att::SCALE; if (key0 + 16 + 4 * g + r >= ST) b = -1e30f; s1[r] = b; mx = fmaxf(mx, b); }
    mx = fmaxf(mx, __shfl_xor(mx, 16)); mx = fmaxf(mx, __shfl_xor(mx, 32));
    const float mn = fmaxf(m_run, mx), alpha = __expf(m_run - mn); m_run = mn;
    float ps = 0.f;
#pragma unroll
    for (int r = 0; r < 4; ++r) { s0[r] = __expf(s0[r] - mn); s1[r] = __expf(s1[r] - mn); ps += s0[r] + s1[r]; }
    ps += __shfl_xor(ps, 16); ps += __shfl_xor(ps, 32);
    l_run = l_run * alpha + ps;
    float ar[4];
#pragma unroll
    for (int r = 0; r < 4; ++r) ar[r] = __shfl(alpha, 4 * g + r);
    u32x4 pw; pw.x = cvtpk(s0[0], s0[1]); pw.y = cvtpk(s0[2], s0[3]); pw.z = cvtpk(s1[0], s1[1]); pw.w = cvtpk(s1[2], s1[3]);
    const bf16x8 pf = *reinterpret_cast<const bf16x8*>(&pw);
#pragma unroll
    for (int db = 0; db < 8; ++db) {
#pragma unroll
      for (int r = 0; r < 4; ++r) o[db][r] *= ar[r];
      o[db] = __builtin_amdgcn_mfma_f32_16x16x32_bf16(pf, *reinterpret_cast<const bf16x8*>(&vw[db]), o[db], 0, 0, 0); }
  }
  const size_t base = (size_t)h * 128 + c * 2 + half;
  if (g == 0) { PM[base * 16 + li] = m_run; PL[base * 16 + li] = l_run; }
#pragma unroll
  for (int db = 0; db < 8; ++db)
#pragma unroll
    for (int r = 0; r < 4; ++r) PO[(base * 16 + 4 * g + r) * 128 + db * 16 + li] = o[db][r];
}
__device__ void meta_attn_combine(int b, const float* PM, const float* PL, const float* PO, const u16* msag, u16* msog, char* lds) {
  const int tid = ltid(), h = b >> 4, r = b & 15;
  float* red = (float*)lds; float* wts = red + 16; float* part = wts + 128;
  const float m_s = tid < 128 ? PM[((size_t)h * 128 + tid) * 16 + r] : -1e30f;
  const float M = block_reduce(m_s, red, true);
  float lw = 0.f; if (tid < 128) { const float w = __expf(m_s - M); wts[tid] = w; lw = PL[((size_t)h * 128 + tid) * 16 + r] * w; }
  const float L = block_reduce(lw, red, false);
  const int d = tid & 127, pt = tid >> 7; float acc = 0.f;
#pragma unroll 8
  for (int s = pt * 32; s < pt * 32 + 32; ++s) acc += PO[(((size_t)h * 128 + s) * 16 + r) * 128 + d] * wts[s];
  part[pt * 128 + d] = acc;
  __syncthreads();
  if (tid < 128) { const float o = (part[tid] + part[128 + tid]) + (part[256 + tid] + part[384 + tid]); const float gv = bf2f(msag[(size_t)r * 1024 + h * 128 + tid]);
    msog[(size_t)r * 1024 + h * 128 + tid] = f2bf(o / L * silu_f(gv)); }
  __syncthreads();
}

template <int K, class F> __device__ __forceinline__ void meta_gemm_wg(const u16* A, const u16* Bt, int N, int t0, int tstride, float* sc, F epi) {
  const int tid = ltid(), lane = tid & 63, wid = tid >> 6; constexpr int KS = K / 8, NST = KS / 32;
  for (int tile = t0; tile < N / 16; tile += tstride) {
    f32x4 acc = {0.f, 0.f, 0.f, 0.f};
    const u16* ap = A + (size_t)(lane & 15) * K + wid * KS + 8 * (lane >> 4); const u16* bp = Bt + (size_t)(tile * 16 + (lane & 15)) * K + wid * KS + 8 * (lane >> 4);
    bf16x8 av[NST], bv[NST];
#pragma unroll
    for (int i = 0; i < NST; ++i) { av[i] = *(const bf16x8*)(ap + i * 32); bv[i] = *(const bf16x8*)(bp + i * 32); }
#pragma unroll
    for (int i = 0; i < NST; ++i) acc = __builtin_amdgcn_mfma_f32_16x16x32_bf16(av[i], bv[i], acc, 0, 0, 0);
    *(f32x4*)(sc + (wid * 64 + lane) * 4) = acc;
    __syncthreads();
    if (wid == 0) { f32x4 s = *(const f32x4*)(sc + lane * 4);
#pragma unroll
      for (int w = 1; w < 8; ++w) s += *(const f32x4*)(sc + (w * 64 + lane) * 4);
      epi(tile * 16 + (lane & 15), (lane >> 4) * 4, s); }
    __syncthreads();
  }
}
template <class F> __device__ __forceinline__ void meta_gemm_mix(const u16* A, const u16* Bt, int t0, int tstride, float* sc, F epi) {
  const int tid = ltid(), lane = tid & 63, wid = tid >> 6;
  for (int tile = t0; tile < 32; tile += tstride) {
    f32x4 acc = {0.f, 0.f, 0.f, 0.f};
    const u16* ap = A + (size_t)(lane & 15) * 1024 + (tile >> 4) * 512 + wid * 64 + 8 * (lane >> 4); const u16* bp = Bt + (size_t)(tile * 16 + (lane & 15)) * 512 + wid * 64 + 8 * (lane >> 4);
    const bf16x8 a0 = *(const bf16x8*)ap, a1 = *(const bf16x8*)(ap + 32), b0 = *(const bf16x8*)bp, b1 = *(const bf16x8*)(bp + 32);
    acc = __builtin_amdgcn_mfma_f32_16x16x32_bf16(a0, b0, acc, 0, 0, 0); acc = __builtin_amdgcn_mfma_f32_16x16x32_bf16(a1, b1, acc, 0, 0, 0);
    *(f32x4*)(sc + (wid * 64 + lane) * 4) = acc;
    __syncthreads();
    if (wid == 0) { f32x4 s = *(const f32x4*)(sc + lane * 4);
#pragma unroll
      for (int w = 1; w < 8; ++w) s += *(const f32x4*)(sc + (w * 64 + lane) * 4);
      epi(tile * 16 + (lane & 15), (lane >> 4) * 4, s); }
    __syncthreads();
  }
}
__device__ __forceinline__ void meta_rstd_wg(const float* hmeta, float* sc2, float* rsl) {
  const int tid = ltid(), lane = tid & 63, wid = tid >> 6; const f32x4* hp = (const f32x4*)(hmeta + (size_t)(lane & 15) * 1024 + wid * 128 + (lane >> 4) * 32); float ss = 0.f;
#pragma unroll
  for (int i = 0; i < 8; ++i) { const f32x4 v = hp[i]; ss += v[0] * v[0] + v[1] * v[1] + v[2] * v[2] + v[3] * v[3]; }
  ss += __shfl_xor(ss, 16); ss += __shfl_xor(ss, 32);
  if (lane < 16) sc2[wid * 16 + lane] = ss;
  __syncthreads();
  if (tid < 16) { float t = 0.f;
#pragma unroll
    for (int w = 0; w < 8; ++w) t += sc2[w * 16 + tid];
    rsl[tid] = rsqrtf(t * (1.f / 1024.f) + EPS); }
  __syncthreads();
}

__device__ void fval_transpose(const u16* fvn, const float* rstd, u16* ut, char* lds) {
  const int tid = ltid(); u16* tile = (u16*)lds;
  for (int job = blockIdx.x; job < 800; job += gridDim.x) {
    const int s2 = job % FN2, cb = job / FN2;
    u32x4 wv[3]; float rv[3];
#pragma unroll
    for (int i = 0; i < 3; ++i) { const int idx = tid + i * 512; if (idx < FN1 * 8) { const int s = FN2 * (idx >> 3) + s2; wv[i] = *(const u32x4*)(fvn + (size_t)s * 512 + cb * 64 + (idx & 7) * 8); rv[i] = rstd[s]; } }
#pragma unroll
    for (int i = 0; i < 3; ++i) { const int idx = tid + i * 512; if (idx < FN1 * 8) { const int s1 = idx >> 3, ch = idx & 7; const u32x4 w = wv[i]; const float rs = rv[i]; u16* tp = tile + (ch * 8) * 168 + s1;
      tp[0 * 168] = f2bf(rs * bflo(w.x)); tp[1 * 168] = f2bf(rs * bfhi(w.x)); tp[2 * 168] = f2bf(rs * bflo(w.y)); tp[3 * 168] = f2bf(rs * bfhi(w.y));
      tp[4 * 168] = f2bf(rs * bflo(w.z)); tp[5 * 168] = f2bf(rs * bfhi(w.z)); tp[6 * 168] = f2bf(rs * bflo(w.w)); tp[7 * 168] = f2bf(rs * bfhi(w.w)); } }
    if (tid < 256) tile[(tid >> 2) * 168 + FN1 + (tid & 3)] = 0;
    __syncthreads();
    for (int idx = tid; idx < 64 * 21; idx += 512) { const int c = idx / 21, k = idx - c * 21;
      *(u32x4*)(ut + ((size_t)(cb * 64 + c) * FN2 + s2) * 256 + k * 8) = *(const u32x4*)(tile + c * 168 + k * 8); }
    __syncthreads();
  }
}
__device__ __forceinline__ int win_src_col(int np) {
  return np < 1024 ? np : (np < 1536 ? np + 1024 : (np < 2560 ? np - 512 : np));
}
__device__ __forceinline__ void transpose_tile(const float* src, int lds_, u16* dst, int ldd, const float* scale, u16* tile, int tl) {
  { const int r = tl >> 3, ch = tl & 7; const float* sp = src + (size_t)r * lds_ + ch * 8; const f32x4 a = *(const f32x4*)sp, b = *(const f32x4*)(sp + 4); const float sc = scale ? scale[r] : 1.f;
#pragma unroll
    for (int i = 0; i < 4; ++i) { tile[(ch * 8 + i) * 66 + r] = f2bf(a[i] * sc); tile[(ch * 8 + 4 + i) * 66 + r] = f2bf(b[i] * sc); } }
  __syncthreads();
  { const int n = tl >> 3, kc = tl & 7; const u16* tp = tile + n * 66 + kc * 8; u32x4 w;
    w.x = (unsigned)tp[0] | ((unsigned)tp[1] << 16); w.y = (unsigned)tp[2] | ((unsigned)tp[3] << 16); w.z = (unsigned)tp[4] | ((unsigned)tp[5] << 16); w.w = (unsigned)tp[6] | ((unsigned)tp[7] << 16);
    *(u32x4*)(dst + (size_t)n * ldd + kc * 8) = w; }
  __syncthreads();
}
__device__ __forceinline__ int transpose_all(const float* src, u16* dst, int K, int N, const float* scale, bool remap, u16* tile, int tl, int t0) {
  const int nkb = K >> 6, nnb = N >> 6, nt = nkb * nnb, G = (int)gridDim.x, r = tl >> 3, ch = tl & 7;
  int t = (int)blockIdx.x - (t0 % G); if (t < 0) t += G;
  f32x4 a = {0.f, 0.f, 0.f, 0.f}, b = a; float sc = 1.f;
  if (t < nt) { const int nb = t % nnb, kb = t / nnb, n0 = remap ? win_src_col(nb * 64) : nb * 64; const float* sp = src + ((size_t)kb * 64 + r) * N + n0 + ch * 8;
    a = *(const f32x4*)sp; b = *(const f32x4*)(sp + 4); sc = scale ? scale[kb * 64 + r] : 1.f; }
  for (; t < nt; t += G) {
#pragma unroll
    for (int i = 0; i < 4; ++i) { tile[(ch * 8 + i) * 66 + r] = f2bf(a[i] * sc); tile[(ch * 8 + 4 + i) * 66 + r] = f2bf(b[i] * sc); }
    __syncthreads();
    const int tn = t + G;
    if (tn < nt) { const int nb = tn % nnb, kb = tn / nnb, n0 = remap ? win_src_col(nb * 64) : nb * 64; const float* sp = src + ((size_t)kb * 64 + r) * N + n0 + ch * 8;
      a = *(const f32x4*)sp; b = *(const f32x4*)(sp + 4); sc = scale ? scale[kb * 64 + r] : 1.f; }
    { const int nb = t % nnb, kb = t / nnb; const int n = tl >> 3, kc = tl & 7; const u16* tp = tile + n * 66 + kc * 8; u32x4 w;
      w.x = (unsigned)tp[0] | ((unsigned)tp[1] << 16); w.y = (unsigned)tp[2] | ((unsigned)tp[3] << 16); w.z = (unsigned)tp[4] | ((unsigned)tp[5] << 16); w.w = (unsigned)tp[6] | ((unsigned)tp[7] << 16);
      *(u32x4*)(dst + ((size_t)nb * 64 + n) * K + kb * 64 + kc * 8) = w; }
    __syncthreads();
  }
  return t0 + nt;
}
__device__ void prep_phase(const Params& p, char* lds) {
  const int tl = ltid(); const size_t gt = (size_t)blockIdx.x * 512 + tl, gs = (size_t)gridDim.x * 512;
  unsigned char* ws = p.ws;
  float* tab = (float*)lds;
  if (tl < 128) { float s, c; sincospif((float)tl / 64.f, &s, &c); tab[tl] = c; tab[128 + tl] = s; }
  __syncthreads();
  int tcur = 0;
  for (int l = 0; l < 2; ++l) {
    u16* tile = (u16*)(lds + 1024);
    tcur = transpose_all(p.w_in + (size_t)l * DM * INW, (u16*)(ws + OFF_WIN + l * SZ_WIN), 1024, INW, p.norm_g + l * DM, true, tile, tl, tcur);
    tcur = transpose_all(p.w_fproj + (size_t)l * 512 * 1024, (u16*)(ws + OFF_WFP + l * SZ_WFP), 512, 1024, nullptr, false, tile, tl, tcur);
    tcur = transpose_all(p.w_aproj + (size_t)l * 1024 * 1024, (u16*)(ws + OFF_WAP + l * SZ_W1K), 1024, 1024, nullptr, false, tile, tl, tcur);
    tcur = transpose_all(p.w_out + (size_t)l * 1024 * 1024, (u16*)(ws + OFF_WOUT + l * SZ_W1K), 1024, 1024, nullptr, false, tile, tl, tcur);
    { u16* dst = (u16*)(ws + OFF_MMIX + l * SZ_MMIX); const float* wm = p.w_fmix + (size_t)l * 4 * 128 * 128;
      for (size_t it = gt; it < (size_t)4 * 2 * 128 * 128; it += gs) {
        const int d = (int)(it & 127), c = (int)((it >> 7) & 127), ri = (int)((it >> 14) & 1), g = (int)(it >> 15);
        const float* wp = wm + (size_t)g * 16384 + d; const float* tb = tab + ri * 128; float a = 0.f;
        for (int cp = 0; cp < 128; ++cp) a += tb[(c * cp) & 127] * wp[(size_t)cp * 128];
        dst[(size_t)(g * 128 + d) * 512 + (g & 1) * 256 + ri * 128 + c] = f2bf(a * 0.08838834764831845f);
      }
      for (size_t it = gt; it < (size_t)512 * 64; it += gs) {
        const int n = (int)(it >> 6), kc = (int)(it & 63);
        if ((kc >> 5) != ((n >> 7) & 1)) { u32x4 z = {0u, 0u, 0u, 0u}; *(u32x4*)(dst + (size_t)n * 512 + kc * 8) = z; }
      } }
  }
  { u16* dst = (u16*)(ws + OFF_F1T);
    for (size_t it = gt; it < (size_t)512 * 256; it += gs) {
      const int col = (int)(it & 255), row = (int)(it >> 8), k1 = (row >> 8) * 128 + (row & 127), ri = (row >> 7) & 1; float v = 0.f;
      if (k1 < FN1 && col < FN1) { float s, c; sincospif((float)(2 * ((k1 * col) % FN1)) / (float)FN1, &s, &c); v = (ri ? -s : c) * 0.07808688094430304f; }
      dst[it] = f2bf(v);
    } }
  { u16* dst = (u16*)(ws + OFF_F2T);
    for (size_t it = gt; it < (size_t)256 * 256; it += gs) {
      const int col = (int)(it & 255), row = (int)(it >> 8), k2 = row & 127, s2 = col & 127, ro = row >> 7, ri = col >> 7; float v = 0.f;
      if (k2 < FN2 && s2 < FN2) { float s, c; sincospif((float)(2 * ((k2 * s2) % FN2)) / (float)FN2, &s, &c); v = (ro == ri ? c : (ro == 0 ? s : -s)) * 0.1f; }
      dst[it] = f2bf(v);
    } }
  { float* tw = (float*)(ws + OFF_TW);
    for (size_t it = gt; it < (size_t)FN1 * FN2; it += gs) { const int s2 = (int)(it % FN2), k1 = (int)(it / FN2); float s, c; sincospif((float)(2 * k1 * s2) / (float)ST, &s, &c); tw[it * 2] = c; tw[it * 2 + 1] = -s; } }
  { float* cs = (float*)(ws + OFF_CS);
    for (size_t it = gt; it < (size_t)256 * 32; it += gs) { const int j = (int)(it & 31), pos = (int)(it >> 5); const float inv = powf(10000.f, -(float)(2 * j) / 64.f); const float ang = (float)pos * inv; cs[it * 2] = cosf(ang); cs[it * 2 + 1] = sinf(ang); } }
  { u32x4* kz = (u32x4*)(ws + OFF_K + (size_t)ST * 512); u32x4* vz = (u32x4*)(ws + OFF_V + (size_t)ST * 512); const u32x4 z = {0u, 0u, 0u, 0u};
    for (size_t it = gt; it < (size_t)(TPAD - ST) * 32; it += gs) { kz[it] = z; vz[it] = z; } }
  { const int lane = tl & 63, gw = blockIdx.x * 8 + (tl >> 6), nw = gridDim.x * 8;
    u16* hb = (u16*)(ws + OFF_HB); float* rstd = (float*)(ws + OFF_RSTD); float* hm = (float*)(ws + OFF_HMETA);
    for (int s0 = gw; s0 < ST; s0 += 2 * nw) {
      f32x4 v[2][4]; const int s1 = s0 + nw; const bool has1 = s1 < ST;
#pragma unroll
      for (int q = 0; q < 2; ++q) { const int s = q ? s1 : s0; if (q == 0 || has1) { const float* src = s < 16 ? p.meta + (size_t)s * 1024 : p.x + (size_t)(s - 16) * 1024;
#pragma unroll
          for (int i = 0; i < 4; ++i) v[q][i] = *(const f32x4*)(src + i * 256 + lane * 4); } }
#pragma unroll
      for (int q = 0; q < 2; ++q) { const int s = q ? s1 : s0; if (q == 0 || has1) { float ss = 0.f;
#pragma unroll
          for (int i = 0; i < 4; ++i) { const f32x4 x = v[q][i]; ss += x[0] * x[0] + x[1] * x[1] + x[2] * x[2] + x[3] * x[3];
            u32x2 w; w.x = cvtpk(x[0], x[1]); w.y = cvtpk(x[2], x[3]); *(u32x2*)(hb + (size_t)s * 1024 + i * 256 + lane * 4) = w;
            if (s < 16) *(f32x4*)(hm + (size_t)s * 1024 + i * 256 + lane * 4) = x; }
          ss = wave_sum(ss);
          if (lane == 0) rstd[s] = s < 16 ? 1.f : rsqrtf(ss * (1.f / 1024.f) + EPS); } }
    } }
}
template <class Epi> __device__ __forceinline__ void run_gemm_sub(PG8_LAS unsigned char* lds, const u16* A, const u16* Bt, int M, int N, int K, int G, int c, const Epi& E, int lda = 0) {
  asm volatile("" : "+s"(K)); asm volatile("" : "+s"(N)); asm volatile("" : "+s"(M));
  pg8::StaticOrder S; S.init(M, N, G, c);
  const unsigned long long pt = probe_t0();
  pg8::gemm_phase<Epi, pg8::StaticOrder, false>(lds, pg8::Gemm{A, Bt, M, N, K, lda}, S, E, nullptr);
  probe_spin(2, pt);
}
template <class Epi> __device__ __forceinline__ void run_gemm(PG8_LAS unsigned char* lds, const u16* A, const u16* Bt, int M, int N, int K, int rot, const Epi& E) {
  (void)rot; run_gemm_sub(lds, A, Bt, M, N, K, (int)gridDim.x, (int)blockIdx.x, E);
}
#define GSYNC() do { const unsigned long long pts = probe_t0(); xcd_barrier(xbar); probe_spin(64, pts); } while (0)
__global__ __launch_bounds__(512, 2) void fwd_megakernel(Params p) {
  extern __shared__ __attribute__((aligned(16))) unsigned char shm[];
  cg::grid_group grid = cg::this_grid();
  PG8_LAS unsigned char* lds3 = (PG8_LAS unsigned char*)shm; char* lds = (char*)shm;
  unsigned char* ws = p.ws;
  volatile LAS unsigned* xst = (volatile LAS unsigned*)(lds3 + 131072);
  if (threadIdx.x < 2) xst[threadIdx.x] = 0u;
  __syncthreads();
  const XcdBarrier xbar = xcd_barrier_post((unsigned*)(ws + OFF_BAR), xst);
  const int nw = gridDim.x * 8;
  u16* hb = (u16*)(ws + OFF_HB); float* ssqp = (float*)(ws + OFF_SSQ); float* rstd = (float*)(ws + OFF_RSTD); float* hmeta = (float*)(ws + OFF_HMETA);
  u16* tb = (u16*)(ws + OFF_T); u16* kb = (u16*)(ws + OFF_K); u16* vb = (u16*)(ws + OFF_V);
  u16* qb = (u16*)(ws + OFF_Q); u16* ag = (u16*)(ws + OFF_AG); u16* mb = ag; u16* gt = (u16*)(ws + OFF_GT);
  u16* msq = (u16*)(ws + OFF_MS); u16* msag = msq + 16 * 1024; u16* msog = msag + 16 * 1024; u16* msgt = msog + 16 * 1024;
  float* PM = (float*)(ws + OFF_PM); float* PL = (float*)(ws + OFF_PL); float* PO = (float*)(ws + OFF_PO);
  u16* ut = (u16*)(ws + OFF_UT); u16* yt = (u16*)(ws + OFF_YT); u16* wb = (u16*)(ws + OFF_WB); u16* fg = (u16*)(ws + OFF_FG);
  const u16* f1t = (const u16*)(ws + OFF_F1T); const u16* f2t = (const u16*)(ws + OFF_F2T); const float* tw = (const float*)(ws + OFF_TW); const float* cs = (const float*)(ws + OFF_CS);

  { const unsigned long long pt = probe_t0(); prep_phase(p, lds); probe_spin(1, pt); }
  grid.sync();


  for (int l = 0; l < 2; ++l) {
#define IDS() const int tid = ltid(), lane = tid & 63, wid = tid >> 6, gw = blockIdx.x * 8 + wid, mw = wid * gridDim.x + blockIdx.x, fwg = gridDim.x >= 256 ? 128 : 0, mhi = (int)blockIdx.x >= fwg ? wid * ((int)gridDim.x - fwg) + (int)blockIdx.x - fwg : (1 << 30), nhi = 8 * ((int)gridDim.x - fwg); (void)lane; (void)wid; (void)gw; (void)mw; (void)mhi; (void)nhi
    const u16* winT = (const u16*)(ws + OFF_WIN + l * SZ_WIN); const u16* wfpT = (const u16*)(ws + OFF_WFP + l * SZ_WFP);
    const u16* wapT = (const u16*)(ws + OFF_WAP + l * SZ_W1K); const u16* woT = (const u16*)(ws + OFF_WOUT + l * SZ_W1K); const u16* mmT = (const u16*)(ws + OFF_MMIX + l * SZ_MMIX);
    const float* bg = p.b_gate + l * 2048; const float* qg = p.q_g + l * 128; const float* kg = p.k_g + l * 128;

    { const unsigned long long ptp = probe_t0(); IDS();
      {
        const bool split = gridDim.x >= 256, lower = blockIdx.x < 128;
        const int Gs = split ? (lower ? 128 : (int)gridDim.x - 128) : (int)gridDim.x, cs_ = split && !lower ? (int)blockIdx.x - 128 : (int)blockIdx.x;
        const int Ns = split ? (lower ? 512 : 1024) : 1536, pn0 = split && !lower ? 2 : 0;
        EpiA E{tb, fg, kb, vb, pn0};
        run_gemm_sub(lds3, hb + 16 * 1024, winT + (size_t)pn0 * 256 * 1024, SEQ, Ns, 1024, Gs, cs_, E); }
      { float* sc = (float*)lds; float* rsl = sc + 2048 + 128;
        const bool msplit = gridDim.x >= 256; const int mt0 = msplit ? (blockIdx.x < 128 ? (int)blockIdx.x : (1 << 20)) : (int)blockIdx.x, mts = msplit ? 128 : (int)gridDim.x;
        if (mt0 < INW / 16) meta_rstd_wg(hmeta, sc + 2048, rsl);
        meta_gemm_wg<1024>(hb, winT, l == 0 ? INW : 1536, mt0, mts, sc, [&](int col, int r0, f32x4 acc) {
#pragma unroll
          for (int j = 0; j < 4; ++j) { const int s = r0 + j; const float vf = acc[j] * rsl[s]; const u16 v = f2bf(vf);
            if (col < 512) tb[(size_t)s * 512 + col] = v; else if (col < 1024) fg[(size_t)s * 512 + col - 512] = v;
            else if (col < 1280) kb[(size_t)s * 256 + col - 1024] = v; else if (col < 1536) vb[(size_t)s * 256 + col - 1280] = v;
            else if (col < 2560) msq[(size_t)s * 1024 + col - 1536] = v; else if (col < 3584) msag[(size_t)s * 1024 + col - 2560] = v;
            else msgt[(size_t)s * 2048 + col - 3584] = f2bf(sigm_f(vf + bg[col - 3584])); } }); }
      if (l > 0) for (int s = 16 + blockIdx.x * 512 + tid; s < ST; s += gridDim.x * 512) rstd[s] = rstd_from_ssqp(ssqp + (size_t)s * 16);
      probe_spin(128, ptp); }
    GSYNC();
    { IDS(); fval_transpose(tb, rstd, ut, lds);
      for (int idx = blockIdx.x * 512 + tid; idx < SEQ * 32; idx += gridDim.x * 512) { const int s = 16 + (idx >> 5); u32x4* vp = (u32x4*)(vb + (size_t)s * 256 + (idx & 31) * 8); const u32x4 w = *vp; const float rs = rstd[s];
        u32x4 o; o.x = cvtpk(rs * bflo(w.x), rs * bfhi(w.x)); o.y = cvtpk(rs * bflo(w.y), rs * bfhi(w.y)); o.z = cvtpk(rs * bflo(w.z), rs * bfhi(w.z)); o.w = cvtpk(rs * bflo(w.w), rs * bfhi(w.w)); *vp = o; } }
    GSYNC();
    { const unsigned long long ptp = probe_t0(); IDS(); EpiF1 E{tw, yt};
      run_gemm(lds3, f1t, ut, 512, 512 * FN2, 256, 0, E);
      fix_all<2>(kb, kg, cs, 0, ST, gw, nw, lane); if (l == 0) fix_all<8>(msq, qg, cs, 0, 16, gw >= 64 ? gw - 64 : gw + nw - 64, nw, lane); probe_spin(256, ptp); }
    GSYNC();
    { const unsigned long long ptp = probe_t0(); IDS(); EpiF2 E{wb}; run_gemm(lds3, f2t, yt, 256, FN1 * 512, 256, 0, E); probe_spin(512, ptp); }
    GSYNC();
#if PROBE_MASK & 65536
    xcd_barrier(xbar); xcd_barrier(xbar); xcd_barrier(xbar);
#endif
    { const unsigned long long ptp = probe_t0(); IDS();
#pragma unroll 1
      for (int pn = 0; pn < 2; ++pn) { EpiMix E{fg, rstd, tb, pn}; int c = (int)blockIdx.x - 64 * pn; if (c < 0) c += (int)gridDim.x;
        run_gemm_sub(lds3, wb + 16 * 1024 + pn * 512, mmT + (size_t)pn * 256 * 512, SEQ, 256, 512, (int)gridDim.x, c, E, 1024); }
      if (l == 0) meta_gemm_mix(wb, mmT, (int)blockIdx.x, (int)gridDim.x, (float*)lds, [&](int col, int r0, f32x4 acc) {
#pragma unroll
        for (int j = 0; j < 4; ++j) { const int s = r0 + j; tb[(size_t)s * 512 + col] = f2bf(acc[j] * silu_f(bf2f(fg[(size_t)s * 512 + col]))); } });
      { const unsigned long long ptm = probe_t0();
        if (l == 0) for (int j = (int)blockIdx.x >= fwg ? (int)blockIdx.x - fwg : (int)blockIdx.x - fwg + (int)gridDim.x; j < 128; j += gridDim.x) meta_attn_partial(j, msq, kb, vb, PM, PL, PO);
        probe_spin(8, ptm); } probe_spin(1024, ptp); }
    GSYNC();
    { const unsigned long long ptp = probe_t0(); IDS(); EpiE E{rstd, bg, qb, ag, gt};
      if (l == 0) for (int b = blockIdx.x; b < 128; b += gridDim.x) meta_attn_combine(b, PM, PL, PO, msag, msog, lds);
      run_gemm(lds3, hb + 16 * 1024, winT + (size_t)1536 * 1024, SEQ, 4096, 1024, 0, E);
      probe_spin(2048, ptp); }
    GSYNC();
    { const unsigned long long ptp = probe_t0(); IDS(); { const unsigned long long ptq = probe_t0(); fix_all<8>(qb, qg, cs, 16, ST, gw, nw, lane); probe_spin(32768, ptq); }
      GSYNC();
      const unsigned long long pta = probe_t0();
      if (__builtin_amdgcn_readfirstlane(threadIdx.x) >= 256) __builtin_amdgcn_s_setprio(1);
      for (int item = blockIdx.x; item < 512; item += gridDim.x) {
        const int h = item >> 6, blk = item & 63, s0 = 16 + blk * 256;
        u16* Qb = qb + (size_t)s0 * 1024 + h * 128;
        att::attn_body(Qb, kb + (h >> 2) * 128, vb + (h >> 2) * 128, Qb, ag + (size_t)s0 * 1024 + h * 128, lds);
      }
      __builtin_amdgcn_s_setprio(0);
      probe_spin(4, pta); probe_spin(4096, ptp); }
    GSYNC();
    { const unsigned long long ptp = probe_t0(); IDS(); EpiG<0> E0{gt, mb}; run_gemm(lds3, tb + 16 * 512, wfpT, SEQ, 1024, 512, 0, E0);
      EpiG<1> E1{gt, mb}; run_gemm(lds3, qb + 16 * 1024, wapT, SEQ, 1024, 1024, 0, E1);
      { float* sc = (float*)lds;
        if (l == 0) for (int tile = blockIdx.x; tile < 64; tile += gridDim.x) {
          f32x4 a1 = {0.f, 0.f, 0.f, 0.f}, a2 = {0.f, 0.f, 0.f, 0.f}; const int col = tile * 16 + (lane & 15), r0 = (lane >> 4) * 4;
          { const u16* ap = tb + (size_t)(lane & 15) * 512 + wid * 64 + 8 * (lane >> 4); const u16* bp = wfpT + (size_t)col * 512 + wid * 64 + 8 * (lane >> 4);
            const u16* ap2 = msog + (size_t)(lane & 15) * 1024 + wid * 128 + 8 * (lane >> 4); const u16* bp2 = wapT + (size_t)col * 1024 + wid * 128 + 8 * (lane >> 4);
            bf16x8 av[6], bv[6];
#pragma unroll
            for (int i = 0; i < 2; ++i) { av[i] = *(const bf16x8*)(ap + i * 32); bv[i] = *(const bf16x8*)(bp + i * 32); }
#pragma unroll
            for (int i = 0; i < 4; ++i) { av[2 + i] = *(const bf16x8*)(ap2 + i * 32); bv[2 + i] = *(const bf16x8*)(bp2 + i * 32); }
#pragma unroll
            for (int i = 0; i < 2; ++i) a1 = __builtin_amdgcn_mfma_f32_16x16x32_bf16(av[i], bv[i], a1, 0, 0, 0);
#pragma unroll
            for (int i = 0; i < 4; ++i) a2 = __builtin_amdgcn_mfma_f32_16x16x32_bf16(av[2 + i], bv[2 + i], a2, 0, 0, 0); }
          *(f32x4*)(sc + (wid * 64 + lane) * 4) = a1; *(f32x4*)(sc + 2048 + (wid * 64 + lane) * 4) = a2;
          __syncthreads();
          if (wid == 0) { f32x4 s1 = *(const f32x4*)(sc + lane * 4), s2 = *(const f32x4*)(sc + 2048 + lane * 4);
#pragma unroll
            for (int w = 1; w < 8; ++w) { s1 += *(const f32x4*)(sc + (w * 64 + lane) * 4); s2 += *(const f32x4*)(sc + 2048 + (w * 64 + lane) * 4); }
#pragma unroll
            for (int j = 0; j < 4; ++j) { const int s = r0 + j; mb[(size_t)s * 1024 + col] = f2bf(bf2f(msgt[(size_t)s * 2048 + col]) * s1[j] + bf2f(msgt[(size_t)s * 2048 + 1024 + col]) * s2[j]); } }
          __syncthreads();
        } } probe_spin(8192, ptp); }
    GSYNC();
    { const unsigned long long ptp = probe_t0(); IDS(); EpiH E{l == 0 ? p.x : p.out, p.out, hb, ssqp};
      run_gemm(lds3, mb + 16 * 1024, woT, SEQ, 1024, 1024, 0, E);
      if (l == 0) meta_gemm_wg<1024>(mb, woT, 1024, (int)blockIdx.x, (int)gridDim.x, (float*)lds, [&](int col, int r0, f32x4 acc) {
#pragma unroll
        for (int j = 0; j < 4; ++j) { const int s = r0 + j; const float v = hmeta[(size_t)s * 1024 + col] + acc[j]; hmeta[(size_t)s * 1024 + col] = v; hb[(size_t)s * 1024 + col] = f2bf(v); } }); probe_spin(16384, ptp); }
    if (l == 0) GSYNC();
  }
}

extern "C" void kernel_launch(void* const* d_in, const int* in_sizes, int n_in, void* d_out, int out_size, void* d_ws, size_t ws_size, hipStream_t stream) {
  static int grid_blocks = 0;
  if (grid_blocks == 0) {
    if (n_in != 11 || out_size != SEQ * DM || ws_size < OFF_XEND) { fprintf(stderr, "kernel_launch: unexpected shapes (n_in %d out %d ws %zu, need ws >= %zu)\n", n_in, out_size, ws_size, (size_t)OFF_XEND); grid_blocks = -1; return; }
    int dev = 0, cus = 0, per_cu = 0;
    (void)hipGetDevice(&dev); (void)hipDeviceGetAttribute(&cus, hipDeviceAttributeMultiprocessorCount, dev);
    if (hipFuncSetAttribute((const void*)fwd_megakernel, hipFuncAttributeMaxDynamicSharedMemorySize, LDS_BYTES) != hipSuccess) { fprintf(stderr, "kernel_launch: hipFuncSetAttribute failed\n"); grid_blocks = -1; return; }
    if (hipOccupancyMaxActiveBlocksPerMultiprocessor(&per_cu, (const void*)fwd_megakernel, 512, LDS_BYTES) != hipSuccess || per_cu < 1) { fprintf(stderr, "kernel_launch: occupancy query says %d blocks per CU\n", per_cu); (void)hipGetLastError(); per_cu = 1; }
    grid_blocks = cus * 1;
    fprintf(stderr, "kernel_launch: grid %d (cus %d, per_cu %d), ws %zu, need %zu\n", grid_blocks, cus, per_cu, ws_size, (size_t)OFF_XEND);
  }
  if (grid_blocks < 0) return;
  Params p{};
  p.x = (const float*)d_in[0]; p.meta = (const float*)d_in[1]; p.norm_g = (const float*)d_in[2]; p.w_in = (const float*)d_in[3]; p.b_gate = (const float*)d_in[4];
  p.q_g = (const float*)d_in[5]; p.k_g = (const float*)d_in[6]; p.w_fmix = (const float*)d_in[7]; p.w_fproj = (const float*)d_in[8]; p.w_aproj = (const float*)d_in[9]; p.w_out = (const float*)d_in[10];
  p.out = (float*)d_out; p.ws = (unsigned char*)d_ws;
  if (hipMemsetAsync((unsigned char*)d_ws + OFF_BAR, 0, 16384, stream) != hipSuccess) { fprintf(stderr, "kernel_launch: memset of the barrier words failed\n"); return; }
  void* args[] = {&p};
  const hipError_t e = hipLaunchCooperativeKernel((const void*)fwd_megakernel, dim3(grid_blocks), dim3(512), args, LDS_BYTES, stream);
  if (e != hipSuccess) fprintf(stderr, "kernel_launch: cooperative launch failed: %s (grid %d)\n", hipGetErrorString(e), grid_blocks);
}
```

```cpp
#include <hip/hip_runtime.h>
#include <hip/hip_bf16.h>
#include <hip/hip_cooperative_groups.h>
#include <cstdio>
namespace cg = cooperative_groups;
namespace pg8 {
#define PG8_LAS __attribute__((address_space(3)))
typedef unsigned short bf16_t;
typedef short bf16x8 __attribute__((ext_vector_type(8)));
typedef float f32x4 __attribute__((ext_vector_type(4)));
typedef unsigned u32x4 __attribute__((ext_vector_type(4)));
constexpr int BM = 256, BK = 64, HALF = 128, HTB = HALF * BK * 2  , STAGE_BYTES = 8 * HTB, NXCD = 8, WGM = 8;

__host__ __device__ __forceinline__ int lds_byte(int r, int c) { const int st = (r >> 4) * 2 + (c >> 5), rr = r & 15, cc = c & 31, ob = rr * 64 + cc * 2; return st * 1024 + (ob ^ (((ob >> 9) & 1) << 5)); }
__host__ __device__ __forceinline__ void stage_rc(int b, int& R, int& C) { const int st = b / 1024, sb = b % 1024, swz = sb ^ (((sb >> 9) & 1) << 5); R = (st >> 1) * 16 + swz / 64; C = (st & 1) * 32 + (swz % 64) / 2; }
__host__ __device__ __forceinline__ int perm32(int rho) { const int n = rho >> 4, i = rho & 15; return 8 * (i >> 2) + 4 * n + (i & 3); }

struct Unit { int pm, pn; };
struct Gemm { const bf16_t* A; const bf16_t* Bt; int M, N, K; int lda; };

struct StaticOrder {
    int nM, nN, nwg, G, c;
    __host__ __device__ void init(int M, int N, int G_, int c_) { nM = M / BM; nN = N / BM; nwg = nM * nN; G = G_; c = c_; }
    __host__ __device__ bool next(int i, Unit& u) const {
        const long L = (long)i * G + c; if (L >= nwg) return false;
        int wgid = (int)L; { const int q = nwg / NXCD, r = nwg % NXCD, xcd = wgid % NXCD, off = wgid / NXCD; wgid = (xcd < r ? xcd * (q + 1) : r * (q + 1) + (xcd - r) * q) + off; }
        const int nig = WGM * nN, gid = wgid / nig, fm = gid * WGM, gsz = (nM - fm) < WGM ? (nM - fm) : WGM;
        u.pm = fm + ((wgid % nig) % gsz); u.pn = (wgid % nig) / gsz; return true;
    }
    __device__ __forceinline__ void a_ready(const Unit&) const {}
    __device__ __forceinline__ void done(const Unit&) const {}
};
template <class Epi, class Sched, bool STAMP = false>
__device__ __forceinline__ void gemm_phase(PG8_LAS unsigned char* lds, const Gemm g, const Sched& S, const Epi& E, unsigned long long* stamps) {
    int tid_l = threadIdx.x; asm volatile("" : "+v"(tid_l));
    const int tid = tid_l, wid = __builtin_amdgcn_readfirstlane(tid >> 6), lane = tid & 63, wr = wid >> 2, wc = wid & 3, fr = lane & 15, fq = lane >> 4;
    const int K = g.K, nt = K / BK, lda = g.lda ? g.lda : K;
    int ts_lo = 0, ts_hi = 0, nts = 0; const unsigned long long rt_entry = STAMP ? (unsigned long long)wall_clock64() : 0ull;
#define PG8_STAMP() do { if (STAMP && wid == 0 && nts < 64) { const unsigned long long _c = (unsigned long long)clock64(); \
        ts_lo = (lane == nts) ? (int)(unsigned)_c : ts_lo; ts_hi = (lane == nts) ? (int)(unsigned)(_c >> 32) : ts_hi; ++nts; } } while (0)
    PG8_STAMP();
    unsigned voffA[2], voffB[2];
#pragma unroll
    for (int i = 0; i < 2; ++i) { int R, C; stage_rc(tid * 16 + i * 8192, R, C); const int Rb = Epi::PERM ? ((R & ~31) + perm32(R & 31)) : R;
        voffA[i] = (unsigned)(R * lda + C) * 2u; voffB[i] = (unsigned)(Rb * K + C) * 2u; }
    const size_t kstep = (size_t)(BK * 2);
    const size_t hstep = (size_t)HALF * K * 2;
    const size_t tstep = 2 * hstep;
    const size_t hstepA = (size_t)HALF * lda * 2, tstepA = 2 * hstepA;
    const unsigned ldsw = (unsigned)wid * 1024u;
    const int aoff = lds_byte(wr * 64 + fr, fq * 8), boff = lds_byte(wc * 32 + fr, fq * 8);
#define PG8_SA(b, h) (((b) * 2 + (h)) * HTB)
#define PG8_SB(b, h) ((4 + (b) * 2 + (h)) * HTB)
#define PG8_STAGE(bufoff, gbase, voff) do { _Pragma("unroll") for (int _i = 0; _i < 2; ++_i) \
        __builtin_amdgcn_global_load_lds((const unsigned*)((const char*)(gbase) + (voff)[_i]), (PG8_LAS unsigned*)(lds + (bufoff) + ldsw + _i * 8192), 16, 0, 0); } while (0)
#define PG8_LDA(dst, b, h) do { _Pragma("unroll") for (int m = 0; m < 4; ++m) _Pragma("unroll") for (int k = 0; k < 2; ++k) dst[m][k] = *(const PG8_LAS bf16x8*)(lds + PG8_SA(b, h) + aoff + m * 2048 + k * 1024); } while (0)
#define PG8_LDB(dst, b, h) do { _Pragma("unroll") for (int n = 0; n < 2; ++n) _Pragma("unroll") for (int k = 0; k < 2; ++k) dst[n][k] = *(const PG8_LAS bf16x8*)(lds + PG8_SB(b, h) + boff + n * 2048 + k * 1024); } while (0)
#define PG8_MMA(ai, bj, At, Bt) do { __builtin_amdgcn_s_setprio(1); _Pragma("unroll") for (int m = 0; m < 4; ++m) _Pragma("unroll") for (int n = 0; n < 2; ++n) _Pragma("unroll") for (int k = 0; k < 2; ++k) \
        acc[ai][bj][m][n] = __builtin_amdgcn_mfma_f32_16x16x32_bf16(Bt[n][k], At[m][k], acc[ai][bj][m][n], 0, 0, 0); __builtin_amdgcn_s_setprio(0); } while (0)
#define PG8_WAIT_V(n) asm volatile("s_waitcnt vmcnt(" #n ")" ::: "memory")
#define PG8_WAIT_L(n) asm volatile("s_waitcnt lgkmcnt(" #n ")" ::: "memory")
#define PG8_BAR __builtin_amdgcn_s_barrier()
#define PG8_SCHED __builtin_amdgcn_sched_barrier(0)
    Unit cur, nxt; int ui = 0;
    if (!S.next(0, cur)) return;
    f32x4 acc[2][2][4][2];
#pragma unroll
    for (int a = 0; a < 2; ++a)
#pragma unroll
        for (int b = 0; b < 2; ++b)
#pragma unroll
            for (int m = 0; m < 4; ++m)
#pragma unroll
                for (int n = 0; n < 2; ++n) acc[a][b][m][n] = (f32x4){0.f, 0.f, 0.f, 0.f};
    bf16x8 At[4][2], B0[2][2], B1[2][2];
    const char* cA = (const char*)g.A + (size_t)cur.pm * tstepA; const char* cB = (const char*)g.Bt + (size_t)cur.pn * tstep;
    S.a_ready(cur);
    PG8_STAGE(PG8_SB(0, 0), cB, voffB); PG8_STAGE(PG8_SA(0, 0), cA, voffA); PG8_STAGE(PG8_SB(0, 1), cB + hstep, voffB); PG8_STAGE(PG8_SA(0, 1), cA + hstepA, voffA);
    if (wr == 1) PG8_BAR;
    PG8_WAIT_V(4); PG8_BAR;
    PG8_STAGE(PG8_SB(1, 0), cB + kstep, voffB); PG8_STAGE(PG8_SA(1, 0), cA + kstep, voffA); PG8_STAGE(PG8_SB(1, 1), cB + hstep + kstep, voffB);
    PG8_WAIT_V(6); PG8_BAR;
    PG8_STAMP();
    for (;;) {
        const bool has_next = S.next(ui + 1, nxt);
        const char* nA = has_next ? (const char*)g.A + (size_t)nxt.pm * tstepA : cA; const char* nB = has_next ? (const char*)g.Bt + (size_t)nxt.pn * tstep : cB;
#pragma unroll 1
        for (int t = 0; t < nt; t += 2) {
            const bool last = (t == nt - 2);
            const char* a1 = cA + (size_t)(t + 1) * kstep;
            const char* a2 = last ? nA : cA + (size_t)(t + 2) * kstep; const char* b2 = last ? nB : cB + (size_t)(t + 2) * kstep;
            const char* a3 = a2 + kstep; const char* b3 = b2 + kstep;
            if (last && has_next) S.a_ready(nxt);
            PG8_LDB(B0, 0, 0); PG8_SCHED; PG8_LDA(At, 0, 0); PG8_STAGE(PG8_SA(1, 1), a1 + hstepA, voffA);
            PG8_WAIT_L(8); PG8_BAR; PG8_WAIT_L(0); PG8_MMA(0, 0, At, B0); PG8_BAR; PG8_SCHED;
            PG8_LDB(B1, 0, 1); PG8_STAGE(PG8_SB(0, 0), b2, voffB);
            PG8_BAR; PG8_WAIT_L(0); PG8_MMA(0, 1, At, B1); PG8_BAR;
            PG8_LDA(At, 0, 1); PG8_STAGE(PG8_SA(0, 0), a2, voffA);
            PG8_BAR; PG8_WAIT_L(0); PG8_MMA(1, 0, At, B0); PG8_BAR; PG8_SCHED;
            PG8_STAGE(PG8_SB(0, 1), b2 + hstep, voffB);
            PG8_WAIT_V(6); PG8_BAR; PG8_MMA(1, 1, At, B1); PG8_BAR;
            PG8_LDB(B0, 1, 0); PG8_SCHED; PG8_LDA(At, 1, 0); PG8_STAGE(PG8_SA(0, 1), a2 + hstepA, voffA);
            PG8_WAIT_L(8); PG8_BAR; PG8_WAIT_L(0); PG8_MMA(0, 0, At, B0); PG8_BAR; PG8_SCHED;
            PG8_LDB(B1, 1, 1); PG8_STAGE(PG8_SB(1, 0), b3, voffB);
            PG8_BAR; PG8_WAIT_L(0); PG8_MMA(0, 1, At, B1); PG8_BAR;
            PG8_LDA(At, 1, 1); PG8_STAGE(PG8_SA(1, 0), a3, voffA);
            PG8_BAR; PG8_WAIT_L(0); PG8_MMA(1, 0, At, B0); PG8_BAR; PG8_SCHED;
            PG8_STAGE(PG8_SB(1, 1), b3 + hstep, voffB);
            PG8_WAIT_V(6); PG8_BAR; PG8_MMA(1, 1, At, B1); PG8_BAR;
        }
        PG8_STAMP();
        if constexpr (!Epi::AFTER_DRAIN) { E(acc, cur, wr, wc, fr, fq); S.done(cur); }
        PG8_STAMP();
        if (!has_next) break;
#pragma unroll
        for (int a = 0; a < 2; ++a)
#pragma unroll
            for (int b = 0; b < 2; ++b)
#pragma unroll
                for (int m = 0; m < 4; ++m)
#pragma unroll
                    for (int n = 0; n < 2; ++n) acc[a][b][m][n] = (f32x4){0.f, 0.f, 0.f, 0.f};
        cur = nxt; cA = nA; cB = nB; ++ui;
    }
    PG8_WAIT_V(0);
    if (wr == 0) PG8_BAR;
    PG8_BAR;
    if constexpr (Epi::AFTER_DRAIN) { E.fused(acc, cur, wr, wc, fr, fq, lds, wid, lane); S.done(cur); }
    PG8_STAMP();
    if (STAMP && wid == 0) { stamps[lane] = lane < nts ? (((unsigned long long)(unsigned)ts_hi << 32) | (unsigned)ts_lo) : 0ull;
        if (lane == 62) stamps[62] = rt_entry; if (lane == 63) stamps[63] = (unsigned long long)wall_clock64(); }
#undef PG8_STAMP
#undef PG8_SA
#undef PG8_SB
#undef PG8_STAGE
#undef PG8_LDA
#undef PG8_LDB
#undef PG8_MMA
#undef PG8_WAIT_V
#undef PG8_WAIT_L
#undef PG8_BAR
#undef PG8_SCHED
}
}

typedef unsigned short u16;
using pg8::bf16x8; using pg8::f32x4; using pg8::u32x4;
typedef short s16x4 __attribute__((ext_vector_type(4)));
typedef float f32x16 __attribute__((ext_vector_type(16)));
typedef float f32x2 __attribute__((ext_vector_type(2)));
typedef unsigned u32x2 __attribute__((ext_vector_type(2)));

constexpr int DM = 1024, SEQ = 16384, NMETA = 16, ST = 16400, TPAD = 16512, INW = 5632;
constexpr int FN1 = 164, FN2 = 100;
constexpr float EPS = 1e-6f;
constexpr size_t SZ_WIN = (size_t)INW * DM * 2, SZ_WFP = (size_t)1024 * 512 * 2, SZ_W1K = (size_t)1024 * 1024 * 2, SZ_MMIX = (size_t)512 * 1024 * 2;
constexpr size_t OFF_WIN = 0, OFF_WFP = OFF_WIN + 2 * SZ_WIN, OFF_WAP = OFF_WFP + 2 * SZ_WFP, OFF_WOUT = OFF_WAP + 2 * SZ_W1K, OFF_MMIX = OFF_WOUT + 2 * SZ_W1K;
constexpr size_t OFF_F1T = OFF_MMIX + 2 * SZ_MMIX, OFF_F2T = OFF_F1T + 512 * 256 * 2, OFF_TW = OFF_F2T + 256 * 256 * 2, OFF_CS = OFF_TW + 131328;
constexpr size_t OFF_HB = OFF_CS + 65536, SZ_T1K = (size_t)TPAD * 1024 * 2, OFF_SSQ = OFF_HB + SZ_T1K, OFF_HMETA = OFF_SSQ + (size_t)ST * 16 * 4;
constexpr size_t OFF_RSTD = OFF_HMETA + 65536, OFF_BAR = OFF_RSTD + 65792, OFF_MS = OFF_BAR + 16384, OFF_PM = OFF_MS + 163840, OFF_PL = OFF_PM + 65536, OFF_PO = OFF_PL + 65536, OFF_T = OFF_PO + (size_t)8 * 128 * 16 * 128 * 4;
constexpr size_t SZ_T512 = (size_t)TPAD * 512 * 2, OFF_K = OFF_T + SZ_T512, SZ_T256 = (size_t)TPAD * 256 * 2, OFF_V = OFF_K + SZ_T256, OFF_X = OFF_V + SZ_T256;
constexpr size_t OFF_Q = OFF_X, OFF_AG = OFF_Q + SZ_T1K, OFF_GT = OFF_AG + SZ_T1K, OFF_XEND = OFF_GT + 2 * SZ_T1K;
constexpr size_t SZ_UT = (size_t)512 * FN2 * 256 * 2, SZ_YT = (size_t)FN1 * 512 * 256 * 2;
constexpr size_t OFF_UT = OFF_X, OFF_YT = OFF_UT + SZ_UT, OFF_WB = OFF_YT + SZ_YT, OFF_FG = OFF_WB + SZ_T1K, OFF_XEND2 = OFF_FG + SZ_T512;
static_assert(OFF_XEND2 <= OFF_XEND, "FFT buffers must fit in the X region");
static_assert(OFF_XEND <= (size_t)256 * 1024 * 1024, "workspace over 256 MiB");
constexpr int LDS_BYTES = 131072 + 1024;

struct Params { const float *x, *meta, *norm_g, *w_in, *b_gate, *q_g, *k_g, *w_fmix, *w_fproj, *w_aproj, *w_out; float* out; unsigned char* ws; };

#ifndef PROBE_MASK
#define PROBE_MASK 0
#endif
__device__ __forceinline__ unsigned long long probe_t0() { return PROBE_MASK ? __builtin_amdgcn_s_memrealtime() : 0ull; }
__device__ __forceinline__ void probe_spin(int bit, unsigned long long t0) {
  if (PROBE_MASK & bit) { const unsigned long long t1 = __builtin_amdgcn_s_memrealtime(), te = t1 + (t1 - t0); while (__builtin_amdgcn_s_memrealtime() < te) __builtin_amdgcn_s_sleep(4); }
}
__device__ __forceinline__ int ltid() { int t = threadIdx.x; asm volatile("" : "+v"(t)); return t; }
typedef __bf16 bf16v2 __attribute__((ext_vector_type(2)));
__device__ __forceinline__ unsigned cvtpk(float lo, float hi) { const f32x2 v = {lo, hi}; const bf16v2 b = __builtin_convertvector(v, bf16v2); return __builtin_bit_cast(unsigned, b); }
__device__ __forceinline__ u16 f2bf(float x) { return (u16)(cvtpk(x, 0.f) & 0xffffu); }
__device__ __forceinline__ float bf2f(u16 b) { return __uint_as_float(((unsigned)b) << 16); }
__device__ __forceinline__ float bflo(unsigned w) { return __uint_as_float(w << 16); }
__device__ __forceinline__ float bfhi(unsigned w) { return __uint_as_float(w & 0xffff0000u); }
__device__ __forceinline__ u32x4 pack8(f32x4 a, f32x4 b) { u32x4 w; w.x = cvtpk(a[0], a[1]); w.y = cvtpk(a[2], a[3]); w.z = cvtpk(b[0], b[1]); w.w = cvtpk(b[2], b[3]); return w; }
__device__ __forceinline__ float silu_f(float x) { return x * __builtin_amdgcn_rcpf(1.f + __expf(-x)); }
__device__ __forceinline__ float sigm_f(float x) { return __builtin_amdgcn_rcpf(1.f + __expf(-x)); }
__device__ __forceinline__ float wave_sum(float v) { for (int o = 32; o > 0; o >>= 1) v += __shfl_xor(v, o); return v; }
__device__ __forceinline__ float rstd_from_ssqp(const float* sp) {
  const f32x4 a = *(const f32x4*)sp, b = *(const f32x4*)(sp + 4), c = *(const f32x4*)(sp + 8), d = *(const f32x4*)(sp + 12);
  const float s = ((a[0] + a[1]) + (a[2] + a[3])) + ((b[0] + b[1]) + (b[2] + b[3])) + ((c[0] + c[1]) + (c[2] + c[3])) + ((d[0] + d[1]) + (d[2] + d[3]));
  return rsqrtf(s * (1.f / 1024.f) + EPS);
}
#define XB_TMO      128
#define XB_XCNT(j)  (256  + 64 * (j))
#define XB_XSUB(j)  (1280 + 64 * (j))
#define XB_XGEN(j)  (2304 + 64 * (j))
#define XB_TOP      3328
#define XB_TOPGEN   3392
#define XCD_BAR_WORDS 3456
#define XB_SPIN_CAP (1u << 18)
#define LAS __attribute__((address_space(3)))

__device__ __forceinline__ unsigned xb_ld(unsigned* p)              { return __hip_atomic_load(p, __ATOMIC_RELAXED, __HIP_MEMORY_SCOPE_AGENT); }
__device__ __forceinline__ unsigned xb_add(unsigned* p, unsigned v) { return __hip_atomic_fetch_add(p, v, __ATOMIC_RELAXED, __HIP_MEMORY_SCOPE_AGENT); }
__device__ __forceinline__ unsigned xb_xcc_id() { return (unsigned)__builtin_amdgcn_s_getreg((3 << 11) | 20) & 0xFu; }
#define XB_SPIN(cond, bar) do { unsigned _sp = 0; while (cond) { __builtin_amdgcn_s_sleep(1); \
    if ((++_sp & 255u) == 0u) { if (xb_ld(&(bar)[XB_TMO])) break; if (_sp > XB_SPIN_CAP) { atomicAdd(&(bar)[XB_TMO], 1u); break; } } } } while (0)

struct XcdBarrier {
    unsigned* bar; unsigned x;
    volatile LAS unsigned* st;
};

__device__ __forceinline__ XcdBarrier xcd_barrier_post(unsigned* bar, volatile LAS unsigned* st) {
    XcdBarrier b; b.bar = bar; b.x = xb_xcc_id(); b.st = st;
    if (threadIdx.x == 0) (void)xb_add(&bar[XB_XCNT(b.x)], 1u);
    return b;
}
__device__ __forceinline__ void xcd_barrier_complete(unsigned* bar, unsigned x, unsigned& nloc, unsigned& nx) {
    const unsigned G = gridDim.x * gridDim.y * gridDim.z;
    unsigned sum, cnt, mine, sp = 0u;
    for (;;) {
        sum = 0u; cnt = 0u; mine = 0u;
#pragma unroll
        for (unsigned j = 0; j < 16; ++j) { const unsigned c = xb_ld(&bar[XB_XCNT(j)]); sum += c; cnt += (c > 0u) ? 1u : 0u; mine = (j == x) ? c : mine; }
        if (sum == G) break;
        __builtin_amdgcn_s_sleep(1);
        if ((++sp & 255u) == 0u) { if (xb_ld(&bar[XB_TMO])) break; if (sp > XB_SPIN_CAP) { atomicAdd(&bar[XB_TMO], 1u); break; } }
    }
    nloc = mine > 0u ? mine : 1u; nx = cnt > 0u ? cnt : 1u;
}

__device__ __forceinline__ void xcd_barrier(const XcdBarrier& b) {
    asm volatile("s_waitcnt vmcnt(0)" ::: "memory");
    __syncthreads();
    if (threadIdx.x == 0) {
        unsigned* bar = b.bar;
        __builtin_amdgcn_s_waitcnt(0);
        unsigned nloc = b.st[0], nx = b.st[1];
        if (nloc == 0u) { xcd_barrier_complete(bar, b.x, nloc, nx); b.st[0] = nloc; b.st[1] = nx; }
        const unsigned old = xb_add(&bar[XB_XSUB(b.x)], 1u);
        const unsigned gen = old / nloc;
        if (old + 1u == (gen + 1u) * nloc) {
            __builtin_amdgcn_fence(__ATOMIC_RELEASE, "agent");
            asm volatile("s_waitcnt vmcnt(0)" ::: "memory");
            const unsigned og = xb_add(&bar[XB_TOP], 1u);
            const unsigned tg = og / nx;
            if (og + 1u == (tg + 1u) * nx) xb_add(&bar[XB_TOPGEN], 1u);
            else XB_SPIN(xb_ld(&bar[XB_TOPGEN]) == tg, bar);
            __builtin_amdgcn_fence(__ATOMIC_ACQUIRE, "agent");
            xb_add(&bar[XB_XGEN(b.x)], 1u);
            asm volatile("s_waitcnt vmcnt(0)" ::: "memory");
        } else {
            XB_SPIN(xb_ld(&bar[XB_XGEN(b.x)]) == gen, bar);
            __builtin_amdgcn_fence(__ATOMIC_ACQUIRE, "agent");
            asm volatile("s_waitcnt vmcnt(0)" ::: "memory");
        }
    }
    __syncthreads();
}

#define EPI_ROWS for (int ai = 0; ai < 2; ++ai) _Pragma("unroll") for (int m = 0; m < 4; ++m)
#define ROW_FENCE() do { asm volatile("" ::: "memory"); __builtin_amdgcn_sched_barrier(0); } while (0)
struct EpiA {
  static constexpr bool PERM = true, AFTER_DRAIN = false;
  u16 *fvn, *fg, *kb, *vb; int pn0;
  __device__ __forceinline__ void operator()(const f32x4 (&acc)[2][2][4][2], const pg8::Unit& u, int wr, int wc, int fr, int fq) const {
#pragma unroll
    EPI_ROWS {
      const int s = 16 + u.pm * 256 + ai * 128 + wr * 64 + m * 16 + fr;
#pragma unroll
      for (int bj = 0; bj < 2; ++bj) {
        const int pn = u.pn + pn0, col = pn * 256 + bj * 128 + wc * 32 + 8 * fq;
        u16* d = (pn < 2) ? fvn + (size_t)s * 512 + col : (pn < 4) ? fg + (size_t)s * 512 + (col - 512) : (pn == 4 ? kb + (size_t)s * 256 + (col - 1024) : vb + (size_t)s * 256 + (col - 1280));
        *(u32x4*)d = pack8(acc[ai][bj][m][0], acc[ai][bj][m][1]);
      }
    }
  }
};
struct EpiF1 {
  static constexpr bool PERM = false, AFTER_DRAIN = false;
  const float* tw; u16* yt;
  __device__ __forceinline__ void operator()(const f32x4 (&acc)[2][2][4][2], const pg8::Unit& u, int wr, int wc, int fr, int fq) const {
#pragma unroll
    for (int m = 0; m < 4; ++m) {
      const int k1 = u.pm * 128 + wr * 64 + m * 16 + fr;
      if (k1 < FN1) {
        f32x4 t0[2][2], t1[2][2]; int colx[2][2], s2[2][2];
#pragma unroll
        for (int bj = 0; bj < 2; ++bj)
#pragma unroll
          for (int n = 0; n < 2; ++n) { const int c0 = u.pn * 256 + bj * 128 + wc * 32 + n * 16 + 4 * fq; colx[bj][n] = c0 / FN2; s2[bj][n] = c0 - colx[bj][n] * FN2;
            const float* tp = tw + (size_t)(k1 * FN2 + s2[bj][n]) * 2; t0[bj][n] = *(const f32x4*)tp; t1[bj][n] = *(const f32x4*)(tp + 4); }
        __builtin_amdgcn_sched_barrier(0);
#pragma unroll
        for (int bj = 0; bj < 2; ++bj)
#pragma unroll
          for (int n = 0; n < 2; ++n) {
            const f32x4 re = acc[0][bj][m][n], im = acc[1][bj][m][n], a0 = t0[bj][n], a1 = t1[bj][n];
            const float yr0 = re[0] * a0[0] - im[0] * a0[1], yi0 = re[0] * a0[1] + im[0] * a0[0];
            const float yr1 = re[1] * a0[2] - im[1] * a0[3], yi1 = re[1] * a0[3] + im[1] * a0[2];
            const float yr2 = re[2] * a1[0] - im[2] * a1[1], yi2 = re[2] * a1[1] + im[2] * a1[0];
            const float yr3 = re[3] * a1[2] - im[3] * a1[3], yi3 = re[3] * a1[3] + im[3] * a1[2];
            u16* d = yt + ((size_t)k1 * 512 + colx[bj][n]) * 256 + s2[bj][n];
            u32x2 a; a.x = cvtpk(yr0, yr1); a.y = cvtpk(yr2, yr3); *(u32x2*)d = a;
            u32x2 b; b.x = cvtpk(yi0, yi1); b.y = cvtpk(yi2, yi3); *(u32x2*)(d + 128) = b;
          }
      }
    }
  }
};
struct EpiF2 {
  static constexpr bool PERM = true, AFTER_DRAIN = false;
  u16* wb;
  __device__ __forceinline__ void operator()(const f32x4 (&acc)[2][2][4][2], const pg8::Unit& u, int wr, int wc, int fr, int fq) const {
#pragma unroll
    EPI_ROWS {
      const int k2 = wr * 64 + m * 16 + fr;
      if (k2 < FN2) {
#pragma unroll
        for (int bj = 0; bj < 2; ++bj) {
          const int n = u.pn * 256 + bj * 128 + wc * 32 + 8 * fq, k1 = n >> 9, col = n & 511, g = col >> 7, c = col & 127;
          *(u32x4*)(wb + (size_t)(k1 + FN1 * k2) * 1024 + g * 256 + ai * 128 + c) = pack8(acc[ai][bj][m][0], acc[ai][bj][m][1]);
        }
      }
    }
  }
};
struct EpiMix {
  static constexpr bool PERM = true, AFTER_DRAIN = false;
  const u16* fg; const float* rstd; u16* t; int pn0;
  __device__ __forceinline__ void operator()(const f32x4 (&acc)[2][2][4][2], const pg8::Unit& u, int wr, int wc, int fr, int fq) const {
    const int col0 = (u.pn + pn0) * 256 + wc * 32 + 8 * fq;
#pragma unroll
    for (int ai = 0; ai < 2; ++ai) {
      const int s0 = 16 + u.pm * 256 + ai * 128 + wr * 64 + fr;
      u32x4 g[4][2]; float rs[4];
#pragma unroll
      for (int m = 0; m < 4; ++m) { rs[m] = rstd[s0 + m * 16];
#pragma unroll
        for (int bj = 0; bj < 2; ++bj) g[m][bj] = *(const u32x4*)(fg + (size_t)(s0 + m * 16) * 512 + col0 + bj * 128); }
      __builtin_amdgcn_sched_barrier(0);
#pragma unroll
      for (int m = 0; m < 4; ++m)
#pragma unroll
        for (int bj = 0; bj < 2; ++bj) { const u32x4 gg = g[m][bj]; const float r = rs[m]; f32x4 v0 = acc[ai][bj][m][0], v1 = acc[ai][bj][m][1];
          v0[0] *= silu_f(r * bflo(gg.x)); v0[1] *= silu_f(r * bfhi(gg.x)); v0[2] *= silu_f(r * bflo(gg.y)); v0[3] *= silu_f(r * bfhi(gg.y));
          v1[0] *= silu_f(r * bflo(gg.z)); v1[1] *= silu_f(r * bfhi(gg.z)); v1[2] *= silu_f(r * bflo(gg.w)); v1[3] *= silu_f(r * bfhi(gg.w));
          *(u32x4*)(t + (size_t)(s0 + m * 16) * 512 + col0 + bj * 128) = pack8(v0, v1); }
    }
  }
};
struct EpiE {
  static constexpr bool PERM = true, AFTER_DRAIN = false;
  const float* rstd; const float* bg; u16 *q, *ag, *gt;
  __device__ __forceinline__ void operator()(const f32x4 (&acc)[2][2][4][2], const pg8::Unit& u, int wr, int wc, int fr, int fq) const {
    float rsv[2][4];
#pragma unroll
    for (int ai = 0; ai < 2; ++ai)
#pragma unroll
      for (int m = 0; m < 4; ++m) rsv[ai][m] = rstd[16 + u.pm * 256 + ai * 128 + wr * 64 + m * 16 + fr];
#pragma unroll
    EPI_ROWS {
      const int s = 16 + u.pm * 256 + ai * 128 + wr * 64 + m * 16 + fr;
      const float rs = rsv[ai][m];
#pragma unroll
      for (int bj = 0; bj < 2; ++bj) {
        const int col = u.pn * 256 + bj * 128 + wc * 32 + 8 * fq;
        f32x4 v0 = acc[ai][bj][m][0] * rs, v1 = acc[ai][bj][m][1] * rs;
        if (u.pn < 4) *(u32x4*)(q + (size_t)s * 1024 + col) = pack8(v0, v1);
        else if (u.pn < 8) *(u32x4*)(ag + (size_t)s * 1024 + (col - 1024)) = pack8(v0, v1);
        else {
          const f32x4 b0 = *(const f32x4*)(bg + col - 2048), b1 = *(const f32x4*)(bg + col - 2048 + 4);
#pragma unroll
          for (int j = 0; j < 4; ++j) { v0[j] = sigm_f(v0[j] + b0[j]); v1[j] = sigm_f(v1[j] + b1[j]); }
          *(u32x4*)(gt + (size_t)s * 2048 + (col - 2048)) = pack8(v0, v1);
        }
      }
    }
  }
};
template <int SECOND> struct EpiG {
  static constexpr bool PERM = true, AFTER_DRAIN = false;
  const u16* gt; u16* mb;
  __device__ __forceinline__ void operator()(const f32x4 (&acc)[2][2][4][2], const pg8::Unit& u, int wr, int wc, int fr, int fq) const {
    const int col0 = u.pn * 256 + wc * 32 + 8 * fq;
#pragma unroll
    for (int ai = 0; ai < 2; ++ai) {
      const int s0 = 16 + u.pm * 256 + ai * 128 + wr * 64 + fr;
      u32x4 g[4][2], p[4][2];
#pragma unroll
      for (int m = 0; m < 4; ++m)
#pragma unroll
        for (int bj = 0; bj < 2; ++bj) { g[m][bj] = *(const u32x4*)(gt + (size_t)(s0 + m * 16) * 2048 + SECOND * 1024 + col0 + bj * 128);
          if (SECOND) p[m][bj] = *(const u32x4*)(mb + (size_t)(s0 + m * 16) * 1024 + col0 + bj * 128); }
      __builtin_amdgcn_sched_barrier(0);
#pragma unroll
      for (int m = 0; m < 4; ++m)
#pragma unroll
        for (int bj = 0; bj < 2; ++bj) { const u32x4 gg = g[m][bj]; f32x4 v0 = acc[ai][bj][m][0], v1 = acc[ai][bj][m][1];
          v0[0] *= bflo(gg.x); v0[1] *= bfhi(gg.x); v0[2] *= bflo(gg.y); v0[3] *= bfhi(gg.y); v1[0] *= bflo(gg.z); v1[1] *= bfhi(gg.z); v1[2] *= bflo(gg.w); v1[3] *= bfhi(gg.w);
          if (SECOND) { const u32x4 pp = p[m][bj]; v0[0] += bflo(pp.x); v0[1] += bfhi(pp.x); v0[2] += bflo(pp.y); v0[3] += bfhi(pp.y); v1[0] += bflo(pp.z); v1[1] += bfhi(pp.z); v1[2] += bflo(pp.w); v1[3] += bfhi(pp.w); }
          *(u32x4*)(mb + (size_t)(s0 + m * 16) * 1024 + col0 + bj * 128) = pack8(v0, v1); }
    }
  }
};
struct EpiH {
  static constexpr bool PERM = true, AFTER_DRAIN = false;
  const float* hin; float* hout; u16* hb; float* ssqp; int last;
  __device__ __forceinline__ void operator()(const f32x4 (&acc)[2][2][4][2], const pg8::Unit& u, int wr, int wc, int fr, int fq) const {
    const int col0 = u.pn * 256 + wc * 32 + 8 * fq;
#pragma unroll
    for (int ai = 0; ai < 2; ++ai) {
      const int r0 = u.pm * 256 + ai * 128 + wr * 64 + fr;
      f32x4 h0[4][2], h1[4][2];
#pragma unroll
      for (int m = 0; m < 4; ++m)
#pragma unroll
        for (int bj = 0; bj < 2; ++bj) { const float* hp = hin + (size_t)(r0 + m * 16) * 1024 + col0 + bj * 128; h0[m][bj] = *(const f32x4*)hp; h1[m][bj] = *(const f32x4*)(hp + 4); }
      __builtin_amdgcn_sched_barrier(0);
#pragma unroll
      for (int m = 0; m < 4; ++m) { const int r = r0 + m * 16; float ss = 0.f;
#pragma unroll
        for (int bj = 0; bj < 2; ++bj) {
          const f32x4 v0 = acc[ai][bj][m][0] + h0[m][bj], v1 = acc[ai][bj][m][1] + h1[m][bj];
          float* op = hout + (size_t)r * 1024 + col0 + bj * 128; *(f32x4*)op = v0; *(f32x4*)(op + 4) = v1;
          if (!last) { *(u32x4*)(hb + (size_t)(16 + r) * 1024 + col0 + bj * 128) = pack8(v0, v1);
#pragma unroll
            for (int j = 0; j < 4; ++j) ss += v0[j] * v0[j] + v1[j] * v1[j]; }
        }
        if (!last) { ss += __shfl_xor(ss, 16); ss += __shfl_xor(ss, 32);
          if (fq == 0) ssqp[(size_t)(16 + r) * 16 + u.pn * 4 + wc] = ss; } }
    }
  }
};
__device__ __forceinline__ void fix_rows4(u16* p  , const float* g, int s, bool valid, const float* cs, int lane) {
  const int c = lane & 15;
  u32x4 w = {0u, 0u, 0u, 0u}; if (valid) w = *(const u32x4*)(p + c * 8);
  float x[8] = {bflo(w.x), bfhi(w.x), bflo(w.y), bfhi(w.y), bflo(w.z), bfhi(w.z), bflo(w.w), bfhi(w.w)};
  float ss = 0.f;
#pragma unroll
  for (int i = 0; i < 8; ++i) ss += x[i] * x[i];
  ss += __shfl_xor(ss, 1); ss += __shfl_xor(ss, 2); ss += __shfl_xor(ss, 4); ss += __shfl_xor(ss, 8);
  const float rs = rsqrtf(ss * (1.f / 128.f) + EPS);
  const f32x4 g0 = *(const f32x4*)(g + c * 8), g1 = *(const f32x4*)(g + c * 8 + 4);
  float y[8], py[8];
#pragma unroll
  for (int i = 0; i < 4; ++i) { y[i] = x[i] * rs * g0[i]; y[4 + i] = x[4 + i] * rs * g1[i]; }
#pragma unroll
  for (int i = 0; i < 8; ++i) py[i] = __shfl_xor(y[i], 4);
  if (s >= 16) {
    const int t = s - 16, pos = (c < 8) ? (t >> 6) : (t & 63); const float* cp = cs + (size_t)(pos * 32 + (c & 3) * 8) * 2;
    const float sg = (c & 4) ? 1.f : -1.f;
#pragma unroll
    for (int i = 0; i < 4; ++i) { const f32x4 v = *(const f32x4*)(cp + i * 4);
      y[2 * i] = y[2 * i] * v[0] + sg * py[2 * i] * v[1]; y[2 * i + 1] = y[2 * i + 1] * v[2] + sg * py[2 * i + 1] * v[3]; }
  }
  if (valid) { u32x4 o; o.x = cvtpk(y[0], y[1]); o.y = cvtpk(y[2], y[3]); o.z = cvtpk(y[4], y[5]); o.w = cvtpk(y[6], y[7]); *(u32x4*)(p + c * 8) = o; }
}
template <int NH> __device__ __forceinline__ void fix_all(u16* buf, const float* g, const float* cs, int s_lo, int s_hi, int gw, int nw, int lane) {
  const int sub = lane >> 4, n = (s_hi - s_lo) * NH;
  for (int base = gw * 4; base < n; base += nw * 4) { const int idx = base + sub; const bool valid = idx < n; const int s = s_lo + idx / NH, hh = idx % NH;
    fix_rows4(buf + (size_t)s * (NH * 128) + hh * 128, g, s, valid, cs, lane); }
}

namespace att {
constexpr int D = 128, NW = 8, QBLK = 32, KVBLK = 64, LDQ = 1024, LDK = 256, LDO = 1024, KVALID = ST, NT = TPAD / KVBLK;
constexpr float SCALE = 0.088388347648318440f, THR = 8.f;
constexpr size_t SHM_V = KVBLK * D * 2, SHM_K = KVBLK * D * 2;
#define KSWZ(row, colB) ((row) * 256 + ((colB) ^ (((row) & 7) << 4)))
#define SBAR() __builtin_amdgcn_sched_barrier(0)
__device__ __forceinline__ int crow(int r, int hi) { return (r & 3) + 8 * (r >> 2) + 4 * hi; }
template <int MODE>
__device__ __forceinline__ void partialSM(f32x16& p0, f32x16& p1, float& m_reg, float& mn, float& alpha) {
  constexpr float C = SCALE * 1.4426950408889634f;
  if (MODE == 1) {
#pragma unroll
    for (int r = 8; r < 16; ++r) p0[r] = -1e30f;
  }
  if (MODE == 2) {
#pragma unroll
    for (int r = 0; r < 16; ++r) p0[r] = -1e30f;
  }
  if (MODE >= 1) {
#pragma unroll
    for (int r = 0; r < 16; ++r) p1[r] = -1e30f;
  }
  float pmax = p0[0];
#pragma unroll
  for (int r = 1; r < 16; ++r) pmax = fmaxf(pmax, p0[r]);
#pragma unroll
  for (int r = 0; r < 16; ++r) pmax = fmaxf(pmax, p1[r]);
  { auto rr = __builtin_amdgcn_permlane32_swap(__float_as_uint(pmax), __float_as_uint(pmax), false, false);
    pmax = fmaxf(__uint_as_float(rr[0]), __uint_as_float(rr[1])); }
  if (__builtin_expect(__all(pmax - m_reg <= THR / SCALE), 1)) { mn = m_reg; alpha = 1.f; }
  else { mn = fmaxf(m_reg, pmax); alpha = __builtin_amdgcn_exp2f((m_reg - mn) * C); m_reg = mn; }
  const float mnC = -mn * C;
#pragma unroll
  for (int r = 0; r < 16; ++r) p0[r] = fmaf(p0[r], C, mnC);
#pragma unroll
  for (int r = 0; r < 16; ++r) p1[r] = fmaf(p1[r], C, mnC);
#pragma unroll
  for (int r = 0; r < 16; ++r) p0[r] = __builtin_amdgcn_exp2f(p0[r]);
}
__device__ __forceinline__ void finishSM(f32x16& p0, f32x16& p1, float alpha, float& l_reg, bf16x8& pa0, bf16x8& pa1, bf16x8& pa2, bf16x8& pa3) {
#pragma unroll
  for (int r = 0; r < 16; ++r) p1[r] = __builtin_amdgcn_exp2f(p1[r]);
  float ps = 0;
#pragma unroll
  for (int r = 0; r < 16; ++r) ps += p0[r];
#pragma unroll
  for (int r = 0; r < 16; ++r) ps += p1[r];
  { auto rr = __builtin_amdgcn_permlane32_swap(__float_as_uint(ps), __float_as_uint(ps), false, false);
    ps = __uint_as_float(rr[0]) + __uint_as_float(rr[1]); }
  l_reg = l_reg * alpha + ps;
#define PK4(P, BASE, OUT) do { unsigned a0 = cvtpk(P[BASE + 0], P[BASE + 1]), a1 = cvtpk(P[BASE + 2], P[BASE + 3]);   \
    unsigned b0 = cvtpk(P[BASE + 4], P[BASE + 5]), b1 = cvtpk(P[BASE + 6], P[BASE + 7]);                              \
    auto r0 = __builtin_amdgcn_permlane32_swap(a0, b0, false, false); auto r1 = __builtin_amdgcn_permlane32_swap(a1, b1, false, false); \
    u32x4 w = {r0[0], r1[0], r0[1], r1[1]}; OUT = *reinterpret_cast<bf16x8*>(&w); } while (0)
  PK4(p0, 0, pa0); PK4(p0, 8, pa1); PK4(p1, 0, pa2); PK4(p1, 8, pa3);
#undef PK4
}
__device__ __forceinline__ void qkt(f32x16& p0, f32x16& p1, const char* Ks, const bf16x8* qr, int r32, int hi) {
  p0 = f32x16{}; p1 = f32x16{};
#pragma unroll
  for (int d0 = 0; d0 < 8; ++d0) { const int cb = (d0 * 16 + hi * 8) * 2;
    const bf16x8 b0 = *reinterpret_cast<const bf16x8*>(Ks + KSWZ(r32, cb));
    const bf16x8 b1 = *reinterpret_cast<const bf16x8*>(Ks + KSWZ(32 + r32, cb));
    p0 = __builtin_amdgcn_mfma_f32_32x32x16_bf16(b0, qr[d0], p0, 0, 0, 0);
    p1 = __builtin_amdgcn_mfma_f32_32x32x16_bf16(b1, qr[d0], p1, 0, 0, 0); }
}
__device__ __forceinline__ int v_st(int k, int c) { const int kk = (k & ~0xC) | ((k & 4) << 1) | ((k & 8) >> 1); return ((kk >> 3) * 4 + (c >> 5)) * 512 + ((kk & 7) * 32 + (c & 31)) * 2; }
__device__ __forceinline__ int v_rd_base(int lane) { return ((lane & 3) << 3) | (((lane >> 2) & 3) << 6) | (((lane >> 4) & 1) << 5) | (((lane >> 5) & 1) << 8); }
constexpr int v_rd_off(int d0, int ks, int half) { return d0 * 512 + ks * 4096 + half * 2048; }
template <int OFF> __device__ __forceinline__ s16x4 tr_read(int vb) {
  s16x4 r; asm volatile("ds_read_b64_tr_b16 %0, %1 offset:%2" : "=&v"(r) : "v"(vb), "i"(OFF) : "memory"); return r;
}
template <int D0> __device__ __forceinline__ void pv_one(f32x16& od, int vb, bf16x8 pa0, bf16x8 pa1, bf16x8 pa2, bf16x8 pa3) {
  const s16x4 l0 = tr_read<v_rd_off(D0, 0, 0)>(vb), h0 = tr_read<v_rd_off(D0, 0, 1)>(vb), l1 = tr_read<v_rd_off(D0, 1, 0)>(vb), h1 = tr_read<v_rd_off(D0, 1, 1)>(vb);
  const s16x4 l2 = tr_read<v_rd_off(D0, 2, 0)>(vb), h2 = tr_read<v_rd_off(D0, 2, 1)>(vb), l3 = tr_read<v_rd_off(D0, 3, 0)>(vb), h3 = tr_read<v_rd_off(D0, 3, 1)>(vb);
  asm volatile("s_waitcnt lgkmcnt(0)" ::: "memory"); SBAR();
#define PK(L, H) (bf16x8){L[0], L[1], L[2], L[3], H[0], H[1], H[2], H[3]}
  od = __builtin_amdgcn_mfma_f32_32x32x16_bf16(pa0, PK(l0, h0), od, 0, 0, 0);
  od = __builtin_amdgcn_mfma_f32_32x32x16_bf16(pa1, PK(l1, h1), od, 0, 0, 0);
  od = __builtin_amdgcn_mfma_f32_32x32x16_bf16(pa2, PK(l2, h2), od, 0, 0, 0);
  od = __builtin_amdgcn_mfma_f32_32x32x16_bf16(pa3, PK(l3, h3), od, 0, 0, 0);
#undef PK
}
__device__ __forceinline__ void pv_d0(f32x16* o, int vb, bf16x8 pa0, bf16x8 pa1, bf16x8 pa2, bf16x8 pa3) {
  pv_one<0>(o[0], vb, pa0, pa1, pa2, pa3); pv_one<1>(o[1], vb, pa0, pa1, pa2, pa3); pv_one<2>(o[2], vb, pa0, pa1, pa2, pa3); pv_one<3>(o[3], vb, pa0, pa1, pa2, pa3);
}
template <int MODE>
__device__ __forceinline__ void pv_sm(f32x16* o, int vb, bf16x8 pa0, bf16x8 pa1, bf16x8 pa2, bf16x8 pa3, f32x16& p0, f32x16& p1, float& m_reg, float& mn, float& alpha) {
  constexpr float C = SCALE * 1.4426950408889634f;
  pv_one<0>(o[0], vb, pa0, pa1, pa2, pa3);
  if (MODE == 1) {
#pragma unroll
    for (int r = 8; r < 16; ++r) p0[r] = -1e30f;
  }
  if (MODE == 2) {
#pragma unroll
    for (int r = 0; r < 16; ++r) p0[r] = -1e30f;
  }
  if (MODE >= 1) {
#pragma unroll
    for (int r = 0; r < 16; ++r) p1[r] = -1e30f;
  }
  float pmax = p0[0];
#pragma unroll
  for (int r = 1; r < 16; ++r) pmax = fmaxf(pmax, p0[r]);
  pv_one<1>(o[1], vb, pa0, pa1, pa2, pa3);
#pragma unroll
  for (int r = 0; r < 16; ++r) pmax = fmaxf(pmax, p1[r]);
  { auto rr = __builtin_amdgcn_permlane32_swap(__float_as_uint(pmax), __float_as_uint(pmax), false, false);
    pmax = fmaxf(__uint_as_float(rr[0]), __uint_as_float(rr[1])); }
  if (__builtin_expect(__all(pmax - m_reg <= THR / SCALE), 1)) { mn = m_reg; alpha = 1.f; }
  else { mn = fmaxf(m_reg, pmax); alpha = __builtin_amdgcn_exp2f((m_reg - mn) * C); m_reg = mn; }
  const float mnC = -mn * C;
  pv_one<2>(o[2], vb, pa0, pa1, pa2, pa3);
#pragma unroll
  for (int r = 0; r < 16; ++r) p0[r] = fmaf(p0[r], C, mnC);
#pragma unroll
  for (int r = 0; r < 16; ++r) p1[r] = fmaf(p1[r], C, mnC);
  pv_one<3>(o[3], vb, pa0, pa1, pa2, pa3);
#pragma unroll
  for (int r = 0; r < 16; ++r) p0[r] = __builtin_amdgcn_exp2f(p0[r]);
}

__device__ __forceinline__ void attn_body(const u16* __restrict__ Qb, const u16* __restrict__ Kh, const u16* __restrict__ Vh, u16* Ob, const u16* __restrict__ Gb, char* lds) {
  const int tid = ltid(), wid = tid >> 6, lane = tid & 63, r32 = lane & 31, hi = lane >> 5;
  char* V_lds = lds; char* K_lds = lds + 2 * SHM_V;
  float* ws = (float*)(lds + 2 * SHM_V + 2 * SHM_K) + wid * 64; float* li_l = ws; float* al_l = ws + 32;
  float m_reg = -1e30f, l_reg = 0; f32x16 o[4] = {}; bf16x8 qr[8];
  const u16* Qw = Qb + (long)(wid * QBLK + r32) * LDQ + hi * 8;
#pragma unroll
  for (int d0 = 0; d0 < 8; ++d0) qr[d0] = *reinterpret_cast<const bf16x8*>(Qw + d0 * 16);
  const int sr = tid >> 4, sc = (tid & 15) * 8, vst0 = v_st(sr, sc), vst1 = v_st(32 + sr, sc);
  const int vb0 = (int)(uintptr_t)V_lds + v_rd_base(lane);
  bf16x8 e_vs0, e_vs1, e_ks0, e_ks1, o_vs0, o_vs1, o_ks0, o_ks1;
#define SLOAD_E(k0) do { e_vs0 = *(const bf16x8*)&Vh[(long)((k0) + sr) * LDK + sc]; e_vs1 = *(const bf16x8*)&Vh[(long)((k0) + 32 + sr) * LDK + sc]; \
    e_ks0 = *(const bf16x8*)&Kh[(long)((k0) + sr) * LDK + sc]; e_ks1 = *(const bf16x8*)&Kh[(long)((k0) + 32 + sr) * LDK + sc]; } while (0)
#define SLOAD_O(k0) do { o_vs0 = *(const bf16x8*)&Vh[(long)((k0) + sr) * LDK + sc]; o_vs1 = *(const bf16x8*)&Vh[(long)((k0) + 32 + sr) * LDK + sc]; \
    o_ks0 = *(const bf16x8*)&Kh[(long)((k0) + sr) * LDK + sc]; o_ks1 = *(const bf16x8*)&Kh[(long)((k0) + 32 + sr) * LDK + sc]; } while (0)
#define SWRITE(b, P) do { *(bf16x8*)(V_lds + (b) * SHM_V + vst0) = P##_vs0; *(bf16x8*)(V_lds + (b) * SHM_V + vst1) = P##_vs1; const int kc = sc * 2; \
    *(bf16x8*)(K_lds + (b) * SHM_K + KSWZ(sr, kc)) = P##_ks0; *(bf16x8*)(K_lds + (b) * SHM_K + KSWZ(32 + sr, kc)) = P##_ks1; } while (0)
#define SWAIT() asm volatile("s_waitcnt vmcnt(4)" ::: "memory")
#define RESC(a) do { if (__any((a) < 1.f)) { if (hi == 0) al_l[r32] = (a); asm volatile("s_waitcnt lgkmcnt(0)" ::: "memory"); \
    _Pragma("unroll") for (int d = 0; d < 4; ++d) _Pragma("unroll") for (int r = 0; r < 16; ++r) o[d][r] *= al_l[crow(r, hi)]; } } while (0)
  f32x16 pA0, pA1, pB0, pB1; float mnA, mnB, alA, alB; bf16x8 pa0, pa1, pa2, pa3;
#define ITER(J, MB, MA, LOADE) do { \
    SBAR(); qkt(pB0, pB1, K_lds + SHM_K, qr, r32, hi); \
    finishSM(pA0, pA1, alA, l_reg, pa0, pa1, pa2, pa3); SBAR(); \
    SLOAD_O(((J) + 2) * KVBLK); SBAR(); \
    pv_sm<MB>(o, vb0, pa0, pa1, pa2, pa3, pB0, pB1, m_reg, mnB, alB); \
    __syncthreads(); SWAIT(); SWRITE(0, e); \
    RESC(alB); __syncthreads(); \
    SBAR(); qkt(pA0, pA1, K_lds, qr, r32, hi); \
    finishSM(pB0, pB1, alB, l_reg, pa0, pa1, pa2, pa3); SBAR(); \
    if (LOADE) SLOAD_E(((J) + 3) * KVBLK); SBAR(); \
    pv_sm<MA>(o, vb0 + (int)SHM_V, pa0, pa1, pa2, pa3, pA0, pA1, m_reg, mnA, alA); \
    __syncthreads(); SWAIT(); SWRITE(1, o); \
    RESC(alA); __syncthreads(); } while (0)
  SLOAD_E(0); asm volatile("s_waitcnt vmcnt(0)" ::: "memory"); SWRITE(0, e); __syncthreads();
  qkt(pA0, pA1, K_lds, qr, r32, hi); partialSM<0>(pA0, pA1, m_reg, mnA, alA);
  SLOAD_O(KVBLK); SLOAD_E(2 * KVBLK);
  SWAIT(); SWRITE(1, o); __syncthreads();
#pragma unroll 1
  for (int j = 1; j < NT - 3; j += 2) ITER(j, 0, 0, 1);
  ITER(NT - 3, 0, 1, 0);
  SBAR(); qkt(pB0, pB1, K_lds + SHM_K, qr, r32, hi);
  finishSM(pA0, pA1, alA, l_reg, pa0, pa1, pa2, pa3); SBAR();
  pv_sm<2>(o, vb0, pa0, pa1, pa2, pa3, pB0, pB1, m_reg, mnB, alB);
  __syncthreads(); RESC(alB);
  finishSM(pB0, pB1, alB, l_reg, pa0, pa1, pa2, pa3); SBAR();
  pv_d0(o, vb0 + (int)SHM_V, pa0, pa1, pa2, pa3);
  __syncthreads();
  if (hi == 0) li_l[r32] = l_reg; asm volatile("s_waitcnt lgkmcnt(0)" ::: "memory");
  { char* Ow = lds + wid * 8192;
#pragma unroll
    for (int r = 0; r < 16; ++r) { const int orow = crow(r, hi); const float rl = __builtin_amdgcn_rcpf(li_l[orow]);
#pragma unroll
      for (int d0 = 0; d0 < 4; ++d0) *(u16*)(Ow + orow * 256 + (d0 * 32 + r32) * 2) = f2bf(o[d0][r] * rl); }
    asm volatile("s_waitcnt lgkmcnt(0)" ::: "memory");
#pragma unroll
    for (int i = 0; i < 8; ++i) { const int id = i * 64 + lane, row = id >> 4, ch = id & 15;
      const u32x4 ov = *(const u32x4*)(Ow + row * 256 + ch * 16); const long gi = (long)(wid * QBLK + row) * LDO + ch * 8; const u32x4 g = *(const u32x4*)(Gb + gi);
      u32x4 w; w.x = cvtpk(bflo(ov.x) * silu_f(bflo(g.x)), bfhi(ov.x) * silu_f(bfhi(g.x))); w.y = cvtpk(bflo(ov.y) * silu_f(bflo(g.y)), bfhi(ov.y) * silu_f(bfhi(g.y)));
      w.z = cvtpk(bflo(ov.z) * silu_f(bflo(g.z)), bfhi(ov.z) * silu_f(bfhi(g.z))); w.w = cvtpk(bflo(ov.w) * silu_f(bflo(g.w)), bfhi(ov.w) * silu_f(bfhi(g.w)));
      *(u32x4*)(Ob + gi) = w; } }
  __syncthreads();
#undef ITER
#undef SLOAD_E
#undef SLOAD_O
#undef SWRITE
#undef SWAIT
#undef RESC
}
}
__device__ __forceinline__ float block_reduce(float v, float* red, bool is_max) {
  const int tl = ltid(), lane = tl & 63, wid = tl >> 6;
  for (int o = 32; o > 0; o >>= 1) { const float t = __shfl_xor(v, o); v = is_max ? fmaxf(v, t) : v + t; }
  __syncthreads();
  if (lane == 0) red[wid] = v;
  __syncthreads();
  float r = red[0];
  for (int i = 1; i < 8; ++i) r = is_max ? fmaxf(r, red[i]) : r + red[i];
  return r;
}
__device__ void meta_attn_partial(int j, const u16* msq, const u16* kb, const u16* vb, float* PM, float* PL, float* PO) {
  const int tid = ltid(), lane = tid & 63, wid = tid >> 6, g = lane >> 4, li = lane & 15;
  const int kvh = j & 1, c = j >> 1, half = wid >> 2, h = kvh * 4 + (wid & 3), step0 = c * 8 + half * 4, nsteps = 4 + ((c == 63 && half == 1) ? 1 : 0);
  bf16x8 qf[4];
#pragma unroll
  for (int ks = 0; ks < 4; ++ks) qf[ks] = *(const bf16x8*)(msq + (size_t)li * 1024 + h * 128 + ks * 32 + g * 8);
  f32x4 o[8];
#pragma unroll
  for (int db = 0; db < 8; ++db) o[db] = (f32x4){0.f, 0.f, 0.f, 0.f};
  float m_run = -1e30f, l_run = 0.f;
  for (int st = 0; st < nsteps; ++st) {
    const int key0 = (step0 + st) * 32;
    f32x4 s0 = {0.f, 0.f, 0.f, 0.f}, s1 = {0.f, 0.f, 0.f, 0.f};
    const u16* kp = kb + (size_t)(key0 + li) * 256 + kvh * 128 + g * 8;
    bf16x8 k0[4], k1[4];
#pragma unroll
    for (int ks = 0; ks < 4; ++ks) { k0[ks] = *(const bf16x8*)(kp + ks * 32); k1[ks] = *(const bf16x8*)(kp + 16 * 256 + ks * 32); }
    const u16* vp = vb + (size_t)(key0 + 4 * g) * 256 + kvh * 128 + li;
    u32x4 vw[8];
#pragma unroll
    for (int db = 0; db < 8; ++db) { const u16* q = vp + db * 16;
      vw[db].x = (unsigned)q[0] | ((unsigned)q[256] << 16); vw[db].y = (unsigned)q[512] | ((unsigned)q[768] << 16);
      vw[db].z = (unsigned)q[16 * 256] | ((unsigned)q[17 * 256] << 16); vw[db].w = (unsigned)q[18 * 256] | ((unsigned)q[19 * 256] << 16); }
#pragma unroll
    for (int ks = 0; ks < 4; ++ks) { s0 = __builtin_amdgcn_mfma_f32_16x16x32_bf16(k0[ks], qf[ks], s0, 0, 0, 0); s1 = __builtin_amdgcn_mfma_f32_16x16x32_bf16(k1[ks], qf[ks], s1, 0, 0, 0); }
    float mx = -1e30f;
#pragma unroll
    for (int r = 0; r < 4; ++r) { float a = s0[r] * att::SCALE; if (key0 + 4 * g + r >= ST) a = -1e30f; s0[r] = a; mx = fmaxf(mx, a);
      float b = s1[r] * att::SCALE; if (key0 + 16 + 4 * g + r >= ST) b = -1e30f; s1[r] = b; mx = fmaxf(mx, b); }
    mx = fmaxf(mx, __shfl_xor(mx, 16)); mx = fmaxf(mx, __shfl_xor(mx, 32));
    const float mn = fmaxf(m_run, mx), alpha = __expf(m_run - mn); m_run = mn;
    float ps = 0.f;
#pragma unroll
    for (int r = 0; r < 4; ++r) { s0[r] = __expf(s0[r] - mn); s1[r] = __expf(s1[r] - mn); ps += s0[r] + s1[r]; }
    ps += __shfl_xor(ps, 16); ps += __shfl_xor(ps, 32);
    l_run = l_run * alpha + ps;
    float ar[4];
#pragma unroll
    for (int r = 0; r < 4; ++r) ar[r] = __shfl(alpha, 4 * g + r);
    u32x4 pw; pw.x = cvtpk(s0[0], s0[1]); pw.y = cvtpk(s0[2], s0[3]); pw.z = cvtpk(s1[0], s1[1]); pw.w = cvtpk(s1[2], s1[3]);
    const bf16x8 pf = *reinterpret_cast<const bf16x8*>(&pw);
#pragma unroll
    for (int db = 0; db < 8; ++db) {
#pragma unroll
      for (int r = 0; r < 4; ++r) o[db][r] *= ar[r];
      o[db] = __builtin_amdgcn_mfma_f32_16x16x32_bf16(pf, *reinterpret_cast<const bf16x8*>(&vw[db]), o[db], 0, 0, 0); }
  }
  const size_t base = (size_t)h * 128 + c * 2 + half;
  if (g == 0) { PM[base * 16 + li] = m_run; PL[base * 16 + li] = l_run; }
#pragma unroll
  for (int db = 0; db < 8; ++db)
#pragma unroll
    for (int r = 0; r < 4; ++r) PO[(base * 16 + 4 * g + r) * 128 + db * 16 + li] = o[db][r];
}
__device__ void meta_attn_combine(int b, const float* PM, const float* PL, const float* PO, const u16* msag, u16* msog, char* lds) {
  const int tid = ltid(), h = b >> 4, r = b & 15;
  float* red = (float*)lds; float* wts = red + 16; float* part = wts + 128;
  const float m_s = tid < 128 ? PM[((size_t)h * 128 + tid) * 16 + r] : -1e30f;
  const float M = block_reduce(m_s, red, true);
  float lw = 0.f; if (tid < 128) { const float w = __expf(m_s - M); wts[tid] = w; lw = PL[((size_t)h * 128 + tid) * 16 + r] * w; }
  const float L = block_reduce(lw, red, false);
  const int d = tid & 127, pt = tid >> 7; float acc = 0.f;
#pragma unroll 8
  for (int s = pt * 32; s < pt * 32 + 32; ++s) acc += PO[(((size_t)h * 128 + s) * 16 + r) * 128 + d] * wts[s];
  part[pt * 128 + d] = acc;
  __syncthreads();
  if (tid < 128) { const float o = (part[tid] + part[128 + tid]) + (part[256 + tid] + part[384 + tid]); const float gv = bf2f(msag[(size_t)r * 1024 + h * 128 + tid]);
    msog[(size_t)r * 1024 + h * 128 + tid] = f2bf(o / L * silu_f(gv)); }
  __syncthreads();
}

template <int K, class F> __device__ __forceinline__ void meta_gemm_wg(const u16* A, const u16* Bt, int N, int t0, int tstride, float* sc, F epi) {
  const int tid = ltid(), lane = tid & 63, wid = tid >> 6; constexpr int KS = K / 8, NST = KS / 32;
  for (int tile = t0; tile < N / 16; tile += tstride) {
    f32x4 acc = {0.f, 0.f, 0.f, 0.f};
    const u16* ap = A + (size_t)(lane & 15) * K + wid * KS + 8 * (lane >> 4); const u16* bp = Bt + (size_t)(tile * 16 + (lane & 15)) * K + wid * KS + 8 * (lane >> 4);
    bf16x8 av[NST], bv[NST];
#pragma unroll
    for (int i = 0; i < NST; ++i) { av[i] = *(const bf16x8*)(ap + i * 32); bv[i] = *(const bf16x8*)(bp + i * 32); }
#pragma unroll
    for (int i = 0; i < NST; ++i) acc = __builtin_amdgcn_mfma_f32_16x16x32_bf16(av[i], bv[i], acc, 0, 0, 0);
    *(f32x4*)(sc + (wid * 64 + lane) * 4) = acc;
    __syncthreads();
    if (wid == 0) { f32x4 s = *(const f32x4*)(sc + lane * 4);
#pragma unroll
      for (int w = 1; w < 8; ++w) s += *(const f32x4*)(sc + (w * 64 + lane) * 4);
      epi(tile * 16 + (lane & 15), (lane >> 4) * 4, s); }
    __syncthreads();
  }
}
template <class F> __device__ __forceinline__ void meta_gemm_mix(const u16* A, const u16* Bt, int t0, int tstride, float* sc, F epi) {
  const int tid = ltid(), lane = tid & 63, wid = tid >> 6;
  for (int tile = t0; tile < 32; tile += tstride) {
    f32x4 acc = {0.f, 0.f, 0.f, 0.f};
    const u16* ap = A + (size_t)(lane & 15) * 1024 + (tile >> 4) * 512 + wid * 64 + 8 * (lane >> 4); const u16* bp = Bt + (size_t)(tile * 16 + (lane & 15)) * 512 + wid * 64 + 8 * (lane >> 4);
    const bf16x8 a0 = *(const bf16x8*)ap, a1 = *(const bf16x8*)(ap + 32), b0 = *(const bf16x8*)bp, b1 = *(const bf16x8*)(bp + 32);
    acc = __builtin_amdgcn_mfma_f32_16x16x32_bf16(a0, b0, acc, 0, 0, 0); acc = __builtin_amdgcn_mfma_f32_16x16x32_bf16(a1, b1, acc, 0, 0, 0);
    *(f32x4*)(sc + (wid * 64 + lane) * 4) = acc;
    __syncthreads();
    if (wid == 0) { f32x4 s = *(const f32x4*)(sc + lane * 4);
#pragma unroll
      for (int w = 1; w < 8; ++w) s += *(const f32x4*)(sc + (w * 64 + lane) * 4);
      epi(tile * 16 + (lane & 15), (lane >> 4) * 4, s); }
    __syncthreads();
  }
}
__device__ __forceinline__ void meta_rstd_wg(const float* hmeta, float* sc2, float* rsl) {
  const int tid = ltid(), lane = tid & 63, wid = tid >> 6; const f32x4* hp = (const f32x4*)(hmeta + (size_t)(lane & 15) * 1024 + wid * 128 + (lane >> 4) * 32); float ss = 0.f;
#pragma unroll
  for (int i = 0; i < 8; ++i) { const f32x4 v = hp[i]; ss += v[0] * v[0] + v[1] * v[1] + v[2] * v[2] + v[3] * v[3]; }
  ss += __shfl_xor(ss, 16); ss += __shfl_xor(ss, 32);
  if (lane < 16) sc2[wid * 16 + lane] = ss;
  __syncthreads();
  if (tid < 16) { float t = 0.f;
#pragma unroll
    for (int w = 0; w < 8; ++w) t += sc2[w * 16 + tid];
    rsl[tid] = rsqrtf(t * (1.f / 1024.f) + EPS); }
  __syncthreads();
}

__device__ void fval_transpose(const u16* fvn, const float* rstd, u16* ut, char* lds) {
  const int tid = ltid(); u16* tile = (u16*)lds;
  for (int job = blockIdx.x; job < 800; job += gridDim.x) {
    const int s2 = job % FN2, cb = job / FN2;
    u32x4 wv[3]; float rv[3];
#pragma unroll
    for (int i = 0; i < 3; ++i) { const int idx = tid + i * 512; if (idx < FN1 * 8) { const int s = FN2 * (idx >> 3) + s2; wv[i] = *(const u32x4*)(fvn + (size_t)s * 512 + cb * 64 + (idx & 7) * 8); rv[i] = rstd[s]; } }
#pragma unroll
    for (int i = 0; i < 3; ++i) { const int idx = tid + i * 512; if (idx < FN1 * 8) { const int s1 = idx >> 3, ch = idx & 7; const u32x4 w = wv[i]; const float rs = rv[i]; u16* tp = tile + (ch * 8) * 168 + s1;
      tp[0 * 168] = f2bf(rs * bflo(w.x)); tp[1 * 168] = f2bf(rs * bfhi(w.x)); tp[2 * 168] = f2bf(rs * bflo(w.y)); tp[3 * 168] = f2bf(rs * bfhi(w.y));
      tp[4 * 168] = f2bf(rs * bflo(w.z)); tp[5 * 168] = f2bf(rs * bfhi(w.z)); tp[6 * 168] = f2bf(rs * bflo(w.w)); tp[7 * 168] = f2bf(rs * bfhi(w.w)); } }
    if (tid < 256) tile[(tid >> 2) * 168 + FN1 + (tid & 3)] = 0;
    __syncthreads();
    for (int idx = tid; idx < 64 * 21; idx += 512) { const int c = idx / 21, k = idx - c * 21;
      *(u32x4*)(ut + ((size_t)(cb * 64 + c) * FN2 + s2) * 256 + k * 8) = *(const u32x4*)(tile + c * 168 + k * 8); }
    __syncthreads();
  }
}
__device__ __forceinline__ int win_src_col(int np) {
  return np < 1024 ? np : (np < 1536 ? np + 1024 : (np < 2560 ? np - 512 : np));
}
__device__ __forceinline__ void transpose_tile(const float* src, int lds_, u16* dst, int ldd, const float* scale, u16* tile, int tl) {
  { const int r = tl >> 3, ch = tl & 7; const float* sp = src + (size_t)r * lds_ + ch * 8; const f32x4 a = *(const f32x4*)sp, b = *(const f32x4*)(sp + 4); const float sc = scale ? scale[r] : 1.f;
#pragma unroll
    for (int i = 0; i < 4; ++i) { tile[(ch * 8 + i) * 66 + r] = f2bf(a[i] * sc); tile[(ch * 8 + 4 + i) * 66 + r] = f2bf(b[i] * sc); } }
  __syncthreads();
  { const int n = tl >> 3, kc = tl & 7; const u16* tp = tile + n * 66 + kc * 8; u32x4 w;
    w.x = (unsigned)tp[0] | ((unsigned)tp[1] << 16); w.y = (unsigned)tp[2] | ((unsigned)tp[3] << 16); w.z = (unsigned)tp[4] | ((unsigned)tp[5] << 16); w.w = (unsigned)tp[6] | ((unsigned)tp[7] << 16);
    *(u32x4*)(dst + (size_t)n * ldd + kc * 8) = w; }
  __syncthreads();
}
__device__ __forceinline__ int transpose_all(const float* src, u16* dst, int K, int N, const float* scale, bool remap, u16* tile, int tl, int t0) {
  const int nkb = K >> 6, nnb = N >> 6, nt = nkb * nnb, G = (int)gridDim.x, r = tl >> 3, ch = tl & 7;
  int t = (int)blockIdx.x - (t0 % G); if (t < 0) t += G;
  f32x4 a = {0.f, 0.f, 0.f, 0.f}, b = a; float sc = 1.f;
  if (t < nt) { const int nb = t % nnb, kb = t / nnb, n0 = remap ? win_src_col(nb * 64) : nb * 64; const float* sp = src + ((size_t)kb * 64 + r) * N + n0 + ch * 8;
    a = *(const f32x4*)sp; b = *(const f32x4*)(sp + 4); sc = scale ? scale[kb * 64 + r] : 1.f; }
  for (; t < nt; t += G) {
#pragma unroll
    for (int i = 0; i < 4; ++i) { tile[(ch * 8 + i) * 66 + r] = f2bf(a[i] * sc); tile[(ch * 8 + 4 + i) * 66 + r] = f2bf(b[i] * sc); }
    __syncthreads();
    const int tn = t + G;
    if (tn < nt) { const int nb = tn % nnb, kb = tn / nnb, n0 = remap ? win_src_col(nb * 64) : nb * 64; const float* sp = src + ((size_t)kb * 64 + r) * N + n0 + ch * 8;
      a = *(const f32x4*)sp; b = *(const f32x4*)(sp + 4); sc = scale ? scale[kb * 64 + r] : 1.f; }
    { const int nb = t % nnb, kb = t / nnb; const int n = tl >> 3, kc = tl & 7; const u16* tp = tile + n * 66 + kc * 8; u32x4 w;
      w.x = (unsigned)tp[0] | ((unsigned)tp[1] << 16); w.y = (unsigned)tp[2] | ((unsigned)tp[3] << 16); w.z = (unsigned)tp[4] | ((unsigned)tp[5] << 16); w.w = (unsigned)tp[6] | ((unsigned)tp[7] << 16);
      *(u32x4*)(dst + ((size_t)nb * 64 + n) * K + kb * 64 + kc * 8) = w; }
    __syncthreads();
  }
  return t0 + nt;
}
__device__ void prep_phase(const Params& p, char* lds) {
  const int tl = ltid(); const size_t gt = (size_t)blockIdx.x * 512 + tl, gs = (size_t)gridDim.x * 512;
  unsigned char* ws = p.ws;
  float* tab = (float*)lds;
  if (tl < 128) { float s, c; sincospif((float)tl / 64.f, &s, &c); tab[tl] = c; tab[128 + tl] = s; }
  __syncthreads();
  int tcur = 0;
  for (int l = 0; l < 2; ++l) {
    u16* tile = (u16*)(lds + 1024);
    tcur = transpose_all(p.w_in + (size_t)l * DM * INW, (u16*)(ws + OFF_WIN + l * SZ_WIN), 1024, INW, p.norm_g + l * DM, true, tile, tl, tcur);
    tcur = transpose_all(p.w_fproj + (size_t)l * 512 * 1024, (u16*)(ws + OFF_WFP + l * SZ_WFP), 512, 1024, nullptr, false, tile, tl, tcur);
    tcur = transpose_all(p.w_aproj + (size_t)l * 1024 * 1024, (u16*)(ws + OFF_WAP + l * SZ_W1K), 1024, 1024, nullptr, false, tile, tl, tcur);
    tcur = transpose_all(p.w_out + (size_t)l * 1024 * 1024, (u16*)(ws + OFF_WOUT + l * SZ_W1K), 1024, 1024, nullptr, false, tile, tl, tcur);
    { u16* dst = (u16*)(ws + OFF_MMIX + l * SZ_MMIX); const float* wm = p.w_fmix + (size_t)l * 4 * 128 * 128;
      for (size_t it = gt; it < (size_t)4 * 2 * 128 * 128; it += gs) {
        const int d = (int)(it & 127), c = (int)((it >> 7) & 127), ri = (int)((it >> 14) & 1), g = (int)(it >> 15);
        const float* wp = wm + (size_t)g * 16384 + d; const float* tb = tab + ri * 128; float a = 0.f;
        for (int cp = 0; cp < 128; ++cp) a += tb[(c * cp) & 127] * wp[(size_t)cp * 128];
        dst[(size_t)(g * 128 + d) * 512 + (g & 1) * 256 + ri * 128 + c] = f2bf(a * 0.08838834764831845f);
      }
      for (size_t it = gt; it < (size_t)512 * 64; it += gs) {
        const int n = (int)(it >> 6), kc = (int)(it & 63);
        if ((kc >> 5) != ((n >> 7) & 1)) { u32x4 z = {0u, 0u, 0u, 0u}; *(u32x4*)(dst + (size_t)n * 512 + kc * 8) = z; }
      } }
  }
  { u16* dst = (u16*)(ws + OFF_F1T);
    for (size_t it = gt; it < (size_t)512 * 256; it += gs) {
      const int col = (int)(it & 255), row = (int)(it >> 8), k1 = (row >> 8) * 128 + (row & 127), ri = (row >> 7) & 1; float v = 0.f;
      if (k1 < FN1 && col < FN1) { float s, c; sincospif((float)(2 * ((k1 * col) % FN1)) / (float)FN1, &s, &c); v = (ri ? -s : c) * 0.07808688094430304f; }
      dst[it] = f2bf(v);
    } }
  { u16* dst = (u16*)(ws + OFF_F2T);
    for (size_t it = gt; it < (size_t)256 * 256; it += gs) {
      const int col = (int)(it & 255), row = (int)(it >> 8), k2 = row & 127, s2 = col & 127, ro = row >> 7, ri = col >> 7; float v = 0.f;
      if (k2 < FN2 && s2 < FN2) { float s, c; sincospif((float)(2 * ((k2 * s2) % FN2)) / (float)FN2, &s, &c); v = (ro == ri ? c : (ro == 0 ? s : -s)) * 0.1f; }
      dst[it] = f2bf(v);
    } }
  { float* tw = (float*)(ws + OFF_TW);
    for (size_t it = gt; it < (size_t)FN1 * FN2; it += gs) { const int s2 = (int)(it % FN2), k1 = (int)(it / FN2); float s, c; sincospif((float)(2 * k1 * s2) / (float)ST, &s, &c); tw[it * 2] = c; tw[it * 2 + 1] = -s; } }
  { float* cs = (float*)(ws + OFF_CS);
    for (size_t it = gt; it < (size_t)256 * 32; it += gs) { const int j = (int)(it & 31), pos = (int)(it >> 5); const float inv = powf(10000.f, -(float)(2 * j) / 64.f); const float ang = (float)pos * inv; cs[it * 2] = cosf(ang); cs[it * 2 + 1] = sinf(ang); } }
  { u32x4* kz = (u32x4*)(ws + OFF_K + (size_t)ST * 512); u32x4* vz = (u32x4*)(ws + OFF_V + (size_t)ST * 512); const u32x4 z = {0u, 0u, 0u, 0u};
    for (size_t it = gt; it < (size_t)(TPAD - ST) * 32; it += gs) { kz[it] = z; vz[it] = z; } }
  { const int lane = tl & 63, gw = blockIdx.x * 8 + (tl >> 6), nw = gridDim.x * 8;
    u16* hb = (u16*)(ws + OFF_HB); float* rstd = (float*)(ws + OFF_RSTD); float* hm = (float*)(ws + OFF_HMETA);
    for (int s0 = gw; s0 < ST; s0 += 2 * nw) {
      f32x4 v[2][4]; const int s1 = s0 + nw; const bool has1 = s1 < ST;
#pragma unroll
      for (int q = 0; q < 2; ++q) { const int s = q ? s1 : s0; if (q == 0 || has1) { const float* src = s < 16 ? p.meta + (size_t)s * 1024 : p.x + (size_t)(s - 16) * 1024;
#pragma unroll
          for (int i = 0; i < 4; ++i) v[q][i] = *(const f32x4*)(src + i * 256 + lane * 4); } }
#pragma unroll
      for (int q = 0; q < 2; ++q) { const int s = q ? s1 : s0; if (q == 0 || has1) { float ss = 0.f;
#pragma unroll
          for (int i = 0; i < 4; ++i) { const f32x4 x = v[q][i]; ss += x[0] * x[0] + x[1] * x[1] + x[2] * x[2] + x[3] * x[3];
            u32x2 w; w.x = cvtpk(x[0], x[1]); w.y = cvtpk(x[2], x[3]); *(u32x2*)(hb + (size_t)s * 1024 + i * 256 + lane * 4) = w;
            if (s < 16) *(f32x4*)(hm + (size_t)s * 1024 + i * 256 + lane * 4) = x; }
          ss = wave_sum(ss);
          if (lane == 0) rstd[s] = s < 16 ? 1.f : rsqrtf(ss * (1.f / 1024.f) + EPS); } }
    } }
}
template <class Epi> __device__ __forceinline__ void run_gemm_sub(PG8_LAS unsigned char* lds, const u16* A, const u16* Bt, int M, int N, int K, int G, int c, const Epi& E, int lda = 0) {
  asm volatile("" : "+s"(K)); asm volatile("" : "+s"(N)); asm volatile("" : "+s"(M));
  pg8::StaticOrder S; S.init(M, N, G, c);
  const unsigned long long pt = probe_t0();
  pg8::gemm_phase<Epi, pg8::StaticOrder, false>(lds, pg8::Gemm{A, Bt, M, N, K, lda}, S, E, nullptr);
  probe_spin(2, pt);
}
template <class Epi> __device__ __forceinline__ void run_gemm(PG8_LAS unsigned char* lds, const u16* A, const u16* Bt, int M, int N, int K, int rot, const Epi& E) {
  (void)rot; run_gemm_sub(lds, A, Bt, M, N, K, (int)gridDim.x, (int)blockIdx.x, E);
}
#define GSYNC() do { const unsigned long long pts = probe_t0(); xcd_barrier(xbar); probe_spin(64, pts); } while (0)
__global__ __launch_bounds__(512, 2) void fwd_megakernel(Params p) {
  extern __shared__ __attribute__((aligned(16))) unsigned char shm[];
  cg::grid_group grid = cg::this_grid();
  PG8_LAS unsigned char* lds3 = (PG8_LAS unsigned char*)shm; char* lds = (char*)shm;
  unsigned char* ws = p.ws;
  volatile LAS unsigned* xst = (volatile LAS unsigned*)(lds3 + 131072);
  if (threadIdx.x < 2) xst[threadIdx.x] = 0u;
  __syncthreads();
  const XcdBarrier xbar = xcd_barrier_post((unsigned*)(ws + OFF_BAR), xst);
  const int nw = gridDim.x * 8;
  u16* hb = (u16*)(ws + OFF_HB); float* ssqp = (float*)(ws + OFF_SSQ); float* rstd = (float*)(ws + OFF_RSTD); float* hmeta = (float*)(ws + OFF_HMETA);
  u16* tb = (u16*)(ws + OFF_T); u16* kb = (u16*)(ws + OFF_K); u16* vb = (u16*)(ws + OFF_V);
  u16* qb = (u16*)(ws + OFF_Q); u16* ag = (u16*)(ws + OFF_AG); u16* mb = ag; u16* gt = (u16*)(ws + OFF_GT);
  u16* msq = (u16*)(ws + OFF_MS); u16* msag = msq + 16 * 1024; u16* msog = msag + 16 * 1024; u16* msgt = msog + 16 * 1024;
  float* PM = (float*)(ws + OFF_PM); float* PL = (float*)(ws + OFF_PL); float* PO = (float*)(ws + OFF_PO);
  u16* ut = (u16*)(ws + OFF_UT); u16* yt = (u16*)(ws + OFF_YT); u16* wb = (u16*)(ws + OFF_WB); u16* fg = (u16*)(ws + OFF_FG);
  const u16* f1t = (const u16*)(ws + OFF_F1T); const u16* f2t = (const u16*)(ws + OFF_F2T); const float* tw = (const float*)(ws + OFF_TW); const float* cs = (const float*)(ws + OFF_CS);

  { const unsigned long long pt = probe_t0(); prep_phase(p, lds); probe_spin(1, pt); }
  grid.sync();


  for (int l = 0; l < 2; ++l) {
#define IDS() const int tid = ltid(), lane = tid & 63, wid = tid >> 6, gw = blockIdx.x * 8 + wid, mw = wid * gridDim.x + blockIdx.x, fwg = gridDim.x >= 256 ? 128 : 0, mhi = (int)blockIdx.x >= fwg ? wid * ((int)gridDim.x - fwg) + (int)blockIdx.x - fwg : (1 << 30), nhi = 8 * ((int)gridDim.x - fwg); (void)lane; (void)wid; (void)gw; (void)mw; (void)mhi; (void)nhi
    const u16* winT = (const u16*)(ws + OFF_WIN + l * SZ_WIN); const u16* wfpT = (const u16*)(ws + OFF_WFP + l * SZ_WFP);
    const u16* wapT = (const u16*)(ws + OFF_WAP + l * SZ_W1K); const u16* woT = (const u16*)(ws + OFF_WOUT + l * SZ_W1K); const u16* mmT = (const u16*)(ws + OFF_MMIX + l * SZ_MMIX);
    const float* bg = p.b_gate + l * 2048; const float* qg = p.q_g + l * 128; const float* kg = p.k_g + l * 128;

    { const unsigned long long ptp = probe_t0(); IDS();
      {
        const bool split = gridDim.x >= 256, lower = blockIdx.x < 128;
        const int Gs = split ? (lower ? 128 : (int)gridDim.x - 128) : (int)gridDim.x, cs_ = split && !lower ? (int)blockIdx.x - 128 : (int)blockIdx.x;
        const int Ns = split ? (lower ? 512 : 1024) : 1536, pn0 = split && !lower ? 2 : 0;
        EpiA E{tb, fg, kb, vb, pn0};
        run_gemm_sub(lds3, hb + 16 * 1024, winT + (size_t)pn0 * 256 * 1024, SEQ, Ns, 1024, Gs, cs_, E); }
      { float* sc = (float*)lds; float* rsl = sc + 2048 + 128;
        const bool msplit = gridDim.x >= 256; const int mt0 = msplit ? (blockIdx.x < 128 ? (int)blockIdx.x : (1 << 20)) : (int)blockIdx.x, mts = msplit ? 128 : (int)gridDim.x;
        if (mt0 < INW / 16) meta_rstd_wg(hmeta, sc + 2048, rsl);
        meta_gemm_wg<1024>(hb, winT, l == 0 ? INW : 1536, mt0, mts, sc, [&](int col, int r0, f32x4 acc) {
#pragma unroll
          for (int j = 0; j < 4; ++j) { const int s = r0 + j; const float vf = acc[j] * rsl[s]; const u16 v = f2bf(vf);
            if (col < 512) tb[(size_t)s * 512 + col] = v; else if (col < 1024) fg[(size_t)s * 512 + col - 512] = v;
            else if (col < 1280) kb[(size_t)s * 256 + col - 1024] = v; else if (col < 1536) vb[(size_t)s * 256 + col - 1280] = v;
            else if (col < 2560) msq[(size_t)s * 1024 + col - 1536] = v; else if (col < 3584) msag[(size_t)s * 1024 + col - 2560] = v;
            else msgt[(size_t)s * 2048 + col - 3584] = f2bf(sigm_f(vf + bg[col - 3584])); } }); }
      if (l > 0) for (int s = 16 + blockIdx.x * 512 + tid; s < ST; s += gridDim.x * 512) rstd[s] = rstd_from_ssqp(ssqp + (size_t)s * 16);
      probe_spin(128, ptp); }
    GSYNC();
    { IDS(); fval_transpose(tb, rstd, ut, lds);
      for (int idx = blockIdx.x * 512 + tid; idx < SEQ * 32; idx += gridDim.x * 512) { const int s = 16 + (idx >> 5); u32x4* vp = (u32x4*)(vb + (size_t)s * 256 + (idx & 31) * 8); const u32x4 w = *vp; const float rs = rstd[s];
        u32x4 o; o.x = cvtpk(rs * bflo(w.x), rs * bfhi(w.x)); o.y = cvtpk(rs * bflo(w.y), rs * bfhi(w.y)); o.z = cvtpk(rs * bflo(w.z), rs * bfhi(w.z)); o.w = cvtpk(rs * bflo(w.w), rs * bfhi(w.w)); *vp = o; } }
    GSYNC();
    { const unsigned long long ptp = probe_t0(); IDS(); EpiF1 E{tw, yt};
      run_gemm(lds3, f1t, ut, 512, 512 * FN2, 256, 0, E);
      fix_all<2>(kb, kg, cs, 0, ST, gw, nw, lane); if (l == 0) fix_all<8>(msq, qg, cs, 0, 16, gw >= 64 ? gw - 64 : gw + nw - 64, nw, lane); probe_spin(256, ptp); }
    GSYNC();
    { const unsigned long long ptp = probe_t0(); IDS(); EpiF2 E{wb}; run_gemm(lds3, f2t, yt, 256, FN1 * 512, 256, 0, E); probe_spin(512, ptp); }
    GSYNC();
#if PROBE_MASK & 65536
    xcd_barrier(xbar); xcd_barrier(xbar); xcd_barrier(xbar);
#endif
    { const unsigned long long ptp = probe_t0(); IDS();
#pragma unroll 1
      for (int pn = 0; pn < 2; ++pn) { EpiMix E{fg, rstd, tb, pn}; int c = (int)blockIdx.x - 64 * pn; if (c < 0) c += (int)gridDim.x;
        run_gemm_sub(lds3, wb + 16 * 1024 + pn * 512, mmT + (size_t)pn * 256 * 512, SEQ, 256, 512, (int)gridDim.x, c, E, 1024); }
      if (l == 0) meta_gemm_mix(wb, mmT, (int)blockIdx.x, (int)gridDim.x, (float*)lds, [&](int col, int r0, f32x4 acc) {
#pragma unroll
        for (int j = 0; j < 4; ++j) { const int s = r0 + j; tb[(size_t)s * 512 + col] = f2bf(acc[j] * silu_f(bf2f(fg[(size_t)s * 512 + col]))); } });
      { const unsigned long long ptm = probe_t0();
        if (l == 0) for (int j = (int)blockIdx.x >= fwg ? (int)blockIdx.x - fwg : (int)blockIdx.x - fwg + (int)gridDim.x; j < 128; j += gridDim.x) meta_attn_partial(j, msq, kb, vb, PM, PL, PO);
        probe_spin(8, ptm); } probe_spin(1024, ptp); }
    GSYNC();
    { const unsigned long long ptp = probe_t0(); IDS(); EpiE E{rstd, bg, qb, ag, gt};
      if (l == 0) for (int b = blockIdx.x; b < 128; b += gridDim.x) meta_attn_combine(b, PM, PL, PO, msag, msog, lds);
      run_gemm(lds3, hb + 16 * 1024, winT + (size_t)1536 * 1024, SEQ, 4096, 1024, 0, E);
      probe_spin(2048, ptp); }
    GSYNC();
    { const unsigned long long ptp = probe_t0(); IDS(); { const unsigned long long ptq = probe_t0(); fix_all<8>(qb, qg, cs, 16, ST, gw, nw, lane); probe_spin(32768, ptq); }
      GSYNC();
      const unsigned long long pta = probe_t0();
      if (__builtin_amdgcn_readfirstlane(threadIdx.x) >= 256) __builtin_amdgcn_s_setprio(1);
      for (int item = blockIdx.x; item < 512; item += gridDim.x) {
        const int h = item >> 6, blk = item & 63, s0 = 16 + blk * 256;
        u16* Qb = qb + (size_t)s0 * 1024 + h * 128;
        att::attn_body(Qb, kb + (h >> 2) * 128, vb + (h >> 2) * 128, Qb, ag + (size_t)s0 * 1024 + h * 128, lds);
      }
      __builtin_amdgcn_s_setprio(0);
      probe_spin(4, pta); probe_spin(4096, ptp); }
    GSYNC();
    { const unsigned long long ptp = probe_t0(); IDS(); EpiG<0> E0{gt, mb}; run_gemm(lds3, tb + 16 * 512, wfpT, SEQ, 1024, 512, 0, E0);
      EpiG<1> E1{gt, mb}; run_gemm(lds3, qb + 16 * 1024, wapT, SEQ, 1024, 1024, 0, E1);
      { float* sc = (float*)lds;
        if (l == 0) for (int tile = blockIdx.x; tile < 64; tile += gridDim.x) {
          f32x4 a1 = {0.f, 0.f, 0.f, 0.f}, a2 = {0.f, 0.f, 0.f, 0.f}; const int col = tile * 16 + (lane & 15), r0 = (lane >> 4) * 4;
          { const u16* ap = tb + (size_t)(lane & 15) * 512 + wid * 64 + 8 * (lane >> 4); const u16* bp = wfpT + (size_t)col * 512 + wid * 64 + 8 * (lane >> 4);
            const u16* ap2 = msog + (size_t)(lane & 15) * 1024 + wid * 128 + 8 * (lane >> 4); const u16* bp2 = wapT + (size_t)col * 1024 + wid * 128 + 8 * (lane >> 4);
            bf16x8 av[6], bv[6];
#pragma unroll
            for (int i = 0; i < 2; ++i) { av[i] = *(const bf16x8*)(ap + i * 32); bv[i] = *(const bf16x8*)(bp + i * 32); }
#pragma unroll
            for (int i = 0; i < 4; ++i) { av[2 + i] = *(const bf16x8*)(ap2 + i * 32); bv[2 + i] = *(const bf16x8*)(bp2 + i * 32); }
#pragma unroll
            for (int i = 0; i < 2; ++i) a1 = __builtin_amdgcn_mfma_f32_16x16x32_bf16(av[i], bv[i], a1, 0, 0, 0);
#pragma unroll
            for (int i = 0; i < 4; ++i) a2 = __builtin_amdgcn_mfma_f32_16x16x32_bf16(av[2 + i], bv[2 + i], a2, 0, 0, 0); }
          *(f32x4*)(sc + (wid * 64 + lane) * 4) = a1; *(f32x4*)(sc + 2048 + (wid * 64 + lane) * 4) = a2;
          __syncthreads();
          if (wid == 0) { f32x4 s1 = *(const f32x4*)(sc + lane * 4), s2 = *(const f32x4*)(sc + 2048 + lane * 4);
#pragma unroll
            for (int w = 1; w < 8; ++w) { s1 += *(const f32x4*)(sc + (w * 64 + lane) * 4); s2 += *(const f32x4*)(sc + 2048 + (w * 64 + lane) * 4); }
#pragma unroll
            for (int j = 0; j < 4; ++j) { const int s = r0 + j; mb[(size_t)s * 1024 + col] = f2bf(bf2f(msgt[(size_t)s * 2048 + col]) * s1[j] + bf2f(msgt[(size_t)s * 2048 + 1024 + col]) * s2[j]); } }
          __syncthreads();
        } } probe_spin(8192, ptp); }
    GSYNC();
    { const unsigned long long ptp = probe_t0(); IDS(); EpiH E{l == 0 ? p.x : p.out, p.out, hb, ssqp, l};
      run_gemm(lds3, mb + 16 * 1024, woT, SEQ, 1024, 1024, 0, E);
      if (l == 0) meta_gemm_wg<1024>(mb, woT, 1024, (int)blockIdx.x, (int)gridDim.x, (float*)lds, [&](int col, int r0, f32x4 acc) {
#pragma unroll
        for (int j = 0; j < 4; ++j) { const int s = r0 + j; const float v = hmeta[(size_t)s * 1024 + col] + acc[j]; hmeta[(size_t)s * 1024 + col] = v; hb[(size_t)s * 1024 + col] = f2bf(v); } }); probe_spin(16384, ptp); }
    if (l == 0) GSYNC();
  }
}

extern "C" void kernel_launch(void* const* d_in, const int* in_sizes, int n_in, void* d_out, int out_size, void* d_ws, size_t ws_size, hipStream_t stream) {
  static int grid_blocks = 0;
  if (grid_blocks == 0) {
    if (n_in != 11 || out_size != SEQ * DM || ws_size < OFF_XEND) { fprintf(stderr, "kernel_launch: unexpected shapes (n_in %d out %d ws %zu, need ws >= %zu)\n", n_in, out_size, ws_size, (size_t)OFF_XEND); grid_blocks = -1; return; }
    int dev = 0, cus = 0, per_cu = 0;
    (void)hipGetDevice(&dev); (void)hipDeviceGetAttribute(&cus, hipDeviceAttributeMultiprocessorCount, dev);
    if (hipFuncSetAttribute((const void*)fwd_megakernel, hipFuncAttributeMaxDynamicSharedMemorySize, LDS_BYTES) != hipSuccess) { fprintf(stderr, "kernel_launch: hipFuncSetAttribute failed\n"); grid_blocks = -1; return; }
    if (hipOccupancyMaxActiveBlocksPerMultiprocessor(&per_cu, (const void*)fwd_megakernel, 512, LDS_BYTES) != hipSuccess || per_cu < 1) { fprintf(stderr, "kernel_launch: occupancy query says %d blocks per CU\n", per_cu); (void)hipGetLastError(); per_cu = 1; }
    grid_blocks = cus * 1;
    fprintf(stderr, "kernel_launch: grid %d (cus %d, per_cu %d), ws %zu, need %zu\n", grid_blocks, cus, per_cu, ws_size, (size_t)OFF_XEND);
  }
  if (grid_blocks < 0) return;
  Params p{};
  p.x = (const float*)d_in[0]; p.meta = (const float*)d_in[1]; p.norm_g = (const float*)d_in[2]; p.w_in = (const float*)d_in[3]; p.b_gate = (const float*)d_in[4];
  p.q_g = (const float*)d_in[5]; p.k_g = (const float*)d_in[6]; p.w_fmix = (const float*)d_in[7]; p.w_fproj = (const float*)d_in[8]; p.w_aproj = (const float*)d_in[9]; p.w_out = (const float*)d_in[10];
  p.out = (float*)d_out; p.ws = (unsigned char*)d_ws;
  if (hipMemsetAsync((unsigned char*)d_ws + OFF_BAR, 0, 16384, stream) != hipSuccess) { fprintf(stderr, "kernel_launch: memset of the barrier words failed\n"); return; }
  void* args[] = {&p};
  const hipError_t e = hipLaunchCooperativeKernel((const void*)fwd_megakernel, dim3(grid_blocks), dim3(512), args, LDS_BYTES, stream);
  if (e != hipSuccess) fprintf(stderr, "kernel_launch: cooperative launch failed: %s (grid %d)\n", hipGetErrorString(e), grid_blocks);
}
```
